# Optimizing an MI355X kernel written in HIP

```python
import math
import jax, jax.numpy as jnp
from jax import lax
import numpy as np

D_MODEL = 1024
BATCH = 8
SEQ = 4096
DEPTH = 2

CHUNK = 64
Q_BLOCK = 128
N_MEM = 256
H_A = 4
DQK_A = 64
DV_A = 2 * DQK_A
H_B = 4
DH_B = 64
LEFT_CHUNKS = 8
REL_MAX = 128
H_C = 4
DH_C = 64
H_IDX = 8
D_IDX = 64
TOPK_MAX = 256
D_MIX = H_A * DV_A + H_B * DH_B + H_C * DH_C
SPLITS = (H_A * 2 * DQK_A, H_A * 2 * DQK_A, H_A * DV_A,
          H_B * DH_B, H_B * DH_B, H_B * DH_B,
          H_C * DH_C, H_C * DH_C, H_C * DH_C,
          H_IDX * D_IDX, D_IDX, H_IDX)
N_IN = sum(SPLITS)
H_X = 4
DH_X = D_MODEL // H_X
D_FF = 2816
N_EXPERTS = 8
TOP_K = 2
D_FF_E = 3584
ALPHA = (2.0 * DEPTH) ** 0.25
BETA = (8.0 * DEPTH) ** -0.25
LN_EPS = 1e-5
RMS_EPS = 1e-6
NEG_INF = -1e30

kernel_name = "hybrid_chunk_causal_diff_band_dsa_moe_encoder"


def _layer_norm(x, g, b):
    xf = x.astype(jnp.float32)
    mu = jnp.mean(xf, axis=-1, keepdims=True)
    var = jnp.mean(jnp.square(xf - mu), axis=-1, keepdims=True)
    y = (xf - mu) * lax.rsqrt(var + LN_EPS) * g.astype(jnp.float32) + b.astype(jnp.float32)
    return y.astype(x.dtype)


def _alibi_slopes():
    n = H_A + H_C
    s = jnp.asarray(2.0 ** (-8.0 * np.arange(1, n + 1) / n), dtype=jnp.float32)
    return s[0::2], s[1::2]


def _chunk_allowed(qpos, kpos):
    return (kpos[None, :] // CHUNK) <= (qpos[:, None] // CHUNK)


def _diff_attention(qa, ka, va, lam, lam_init, gain, slopes):
    b, s_len = qa.shape[0], qa.shape[1]
    nb = s_len // Q_BLOCK
    q_blocks = jnp.swapaxes(qa.reshape(b, nb, Q_BLOCK, H_A, 2, DQK_A), 0, 1)
    kpos = jnp.arange(s_len)
    scale = DQK_A ** -0.5

    def block(args):
        qb, i = args
        qpos = i * Q_BLOCK + jnp.arange(Q_BLOCK)
        sc = jnp.einsum('bqhmd,bkhmd->bhmqk', qb, ka).astype(jnp.float32) * scale
        dist = jnp.abs(qpos[:, None] - kpos[None, :]).astype(jnp.float32)
        sc = sc - slopes[None, :, None, None, None] * dist
        sc = jnp.where(_chunk_allowed(qpos, kpos), sc, NEG_INF)
        p = jax.nn.softmax(sc, axis=-1)
        a = p[:, :, 0] - lam * p[:, :, 1]
        return jnp.einsum('bhqk,bkhe->bqhe', a.astype(va.dtype), va)

    o = lax.map(block, (q_blocks, jnp.arange(nb)))
    o = jnp.swapaxes(o, 0, 1).reshape(b, s_len, H_A, DV_A).astype(jnp.float32)
    o = o * lax.rsqrt(jnp.mean(jnp.square(o), axis=-1, keepdims=True) + RMS_EPS)
    o = o * gain.astype(jnp.float32) * (1.0 - lam_init)
    return o.reshape(b, s_len, H_A * DV_A).astype(va.dtype)


def _band_attention(qb, kb, vb, table):
    b, s_len = qb.shape[0], qb.shape[1]
    nc = s_len // CHUNK
    left = LEFT_CHUNKS * CHUNK
    band = (LEFT_CHUNKS + 1) * CHUNK
    qc = qb.reshape(b, nc, CHUNK, H_B, DH_B)

    def gather_band(t):
        tp = jnp.pad(t, ((0, 0), (left, 0), (0, 0), (0, 0)))
        tp = tp.reshape(b, nc + LEFT_CHUNKS, CHUNK, H_B, DH_B)
        return jnp.concatenate([tp[:, j:j + nc] for j in range(LEFT_CHUNKS + 1)], axis=2)

    kband = gather_band(kb)
    vband = gather_band(vb)
    sc = jnp.einsum('bcqhd,bckhd->bchqk', qc, kband).astype(jnp.float32) * DH_B ** -0.5
    qi = jnp.arange(CHUNK)
    kj = jnp.arange(band)
    rel = qi[:, None] - (kj[None, :] - left)
    bias = table[:, jnp.clip(rel, -REL_MAX, REL_MAX) + REL_MAX].astype(jnp.float32)
    kabs = jnp.arange(nc)[:, None] * CHUNK + kj[None, :] - left
    sc = sc + bias[None, None]
    sc = jnp.where((kabs >= 0)[None, :, None, None, :], sc, NEG_INF)
    p = jax.nn.softmax(sc, axis=-1)
    o = jnp.einsum('bchqk,bckhd->bcqhd', p.astype(vb.dtype), vband)
    return o.reshape(b, s_len, H_B * DH_B)


def _dsa_attention(qc, kc, vc, qi, ki, wi, slopes):
    b, s_len = qc.shape[0], qc.shape[1]
    nb = s_len // Q_BLOCK
    topk = min(TOPK_MAX, s_len // 4)
    kpos = jnp.arange(s_len)

    def to_blocks(t):
        return jnp.swapaxes(t.reshape((b, nb, Q_BLOCK) + t.shape[2:]), 0, 1)

    def block(args):
        qb, qib, wib, i = args
        qpos = i * Q_BLOCK + jnp.arange(Q_BLOCK)
        dots = jnp.einsum('bqhd,bsd->bqhs', qib, ki).astype(jnp.float32) * D_IDX ** -0.5
        isc = jnp.einsum('bqhs,bqh->bqs', jax.nn.relu(dots), wib.astype(jnp.float32)) * H_IDX ** -0.5
        isc = jnp.where(_chunk_allowed(qpos, kpos)[None], isc, NEG_INF)
        top_val, top_idx = lax.top_k(isc, topk)
        kg = jax.vmap(lambda t, ix: t[ix])(kc, top_idx)
        vg = jax.vmap(lambda t, ix: t[ix])(vc, top_idx)
        sc = jnp.einsum('bqhd,bqkhd->bhqk', qb, kg).astype(jnp.float32) * DH_C ** -0.5
        dist = jnp.abs(qpos[None, :, None] - top_idx).astype(jnp.float32)
        sc = sc - slopes[None, :, None, None] * dist[:, None]
        sc = jnp.where((top_val > 0.5 * NEG_INF)[:, None], sc, NEG_INF)
        p = jax.nn.softmax(sc, axis=-1)
        return jnp.einsum('bhqk,bqkhd->bqhd', p.astype(vc.dtype), vg)

    o = lax.map(block, (to_blocks(qc), to_blocks(qi), to_blocks(wi), jnp.arange(nb)))
    return jnp.swapaxes(o, 0, 1).reshape(b, s_len, H_C * DH_C)


def _hybrid_mixer(h, w_in, lq1, lk1, lq2, lk2, dgain, rel_table, w_out, layer_idx, slopes_a, slopes_c):
    b, s_len, _ = h.shape
    proj = h @ w_in
    offsets = [int(o) for o in np.cumsum(SPLITS)[:-1]]
    qa, ka, va, qb, kb, vb, qc, kc, vc, qi, ki, wi = jnp.split(proj, offsets, axis=-1)
    lam_init = 0.8 - 0.6 * math.exp(-0.3 * layer_idx)
    lam = (jnp.exp(jnp.sum(lq1.astype(jnp.float32) * lk1.astype(jnp.float32)))
           - jnp.exp(jnp.sum(lq2.astype(jnp.float32) * lk2.astype(jnp.float32))) + lam_init)
    ya = _diff_attention(qa.reshape(b, s_len, H_A, 2, DQK_A), ka.reshape(b, s_len, H_A, 2, DQK_A),
                         va.reshape(b, s_len, H_A, DV_A), lam, lam_init, dgain, slopes_a)
    yb = _band_attention(qb.reshape(b, s_len, H_B, DH_B), kb.reshape(b, s_len, H_B, DH_B),
                         vb.reshape(b, s_len, H_B, DH_B), rel_table)
    yc = _dsa_attention(qc.reshape(b, s_len, H_C, DH_C), kc.reshape(b, s_len, H_C, DH_C),
                        vc.reshape(b, s_len, H_C, DH_C), qi.reshape(b, s_len, H_IDX, D_IDX),
                        ki, wi, slopes_c)
    return jnp.concatenate([ya, yb, yc], axis=-1) @ w_out


def _mem_cross_attention(h, mem, wq, wk, wv, wo):
    b, s_len, _ = h.shape
    q = (h @ wq).reshape(b, s_len, H_X, DH_X)
    k = (mem @ wk).reshape(b, -1, H_X, DH_X)
    v = (mem @ wv).reshape(b, -1, H_X, DH_X)
    sc = jnp.einsum('bqhd,bkhd->bhqk', q, k).astype(jnp.float32) * DH_X ** -0.5
    p = jax.nn.softmax(sc, axis=-1)
    o = jnp.einsum('bhqk,bkhd->bqhd', p.astype(v.dtype), v).reshape(b, s_len, D_MODEL)
    return o @ wo


def _swiglu(h, w1, w3, w2):
    return (jax.nn.silu(h @ w1) * (h @ w3)) @ w2


def _moe(h, router, w1, w3, w2):
    b, s_len, d = h.shape
    t = h.reshape(-1, d)
    logits = (t @ router).astype(jnp.float32)
    top_val, top_idx = lax.top_k(logits, TOP_K)
    gates = jax.nn.softmax(top_val, axis=-1)
    gate_full = jnp.sum(jax.nn.one_hot(top_idx, N_EXPERTS, dtype=jnp.float32) * gates[..., None], axis=1)
    out = jnp.zeros_like(t)
    for e in range(N_EXPERTS):
        out = out + gate_full[:, e:e + 1].astype(t.dtype) * _swiglu(t, w1[e], w3[e], w2[e])
    return out.reshape(b, s_len, d)


def setup_inputs(seed: int = 0) -> dict:
    key = jax.random.key(seed)
    ks = jax.random.split(key, 27)

    def nrm(k, shape, scale):
        return jax.random.normal(k, shape, jnp.float32) * scale

    n_dense = (DEPTH + 1) // 2
    n_moe = DEPTH // 2
    return {
        'x': nrm(ks[0], (BATCH, SEQ, D_MODEL), 1.0),
        'mem': nrm(ks[1], (BATCH, N_MEM, D_MODEL), 1.0),
        'w_in': nrm(ks[2], (DEPTH, D_MODEL, N_IN), D_MODEL ** -0.5),
        'lam_q1': nrm(ks[3], (DEPTH, DQK_A), 0.1),
        'lam_k1': nrm(ks[4], (DEPTH, DQK_A), 0.1),
        'lam_q2': nrm(ks[5], (DEPTH, DQK_A), 0.1),
        'lam_k2': nrm(ks[6], (DEPTH, DQK_A), 0.1),
        'diff_norm_g': 1.0 + nrm(ks[7], (DEPTH, DV_A), 0.02),
        'rel_bias': nrm(ks[8], (DEPTH, H_B, 2 * REL_MAX + 1), 0.1),
        'w_out': nrm(ks[9], (DEPTH, D_MIX, D_MODEL), D_MIX ** -0.5 * BETA),
        'ln1_g': 1.0 + nrm(ks[10], (DEPTH, D_MODEL), 0.02),
        'ln1_b': nrm(ks[11], (DEPTH, D_MODEL), 0.02),
        'xattn_wq': nrm(ks[12], (DEPTH, D_MODEL, D_MODEL), D_MODEL ** -0.5),
        'xattn_wk': nrm(ks[13], (DEPTH, D_MODEL, D_MODEL), D_MODEL ** -0.5),
        'xattn_wv': nrm(ks[14], (DEPTH, D_MODEL, D_MODEL), D_MODEL ** -0.5),
        'xattn_wo': nrm(ks[15], (DEPTH, D_MODEL, D_MODEL), D_MODEL ** -0.5 * BETA),
        'ln2_g': 1.0 + nrm(ks[16], (DEPTH, D_MODEL), 0.02),
        'ln2_b': nrm(ks[17], (DEPTH, D_MODEL), 0.02),
        'ffn_w1': nrm(ks[18], (n_dense, D_MODEL, D_FF), D_MODEL ** -0.5),
        'ffn_w3': nrm(ks[19], (n_dense, D_MODEL, D_FF), D_MODEL ** -0.5),
        'ffn_w2': nrm(ks[20], (n_dense, D_FF, D_MODEL), D_FF ** -0.5 * BETA),
        'moe_router': nrm(ks[21], (n_moe, D_MODEL, N_EXPERTS), D_MODEL ** -0.5),
        'moe_w1': nrm(ks[22], (n_moe, N_EXPERTS, D_MODEL, D_FF_E), D_MODEL ** -0.5),
        'moe_w3': nrm(ks[23], (n_moe, N_EXPERTS, D_MODEL, D_FF_E), D_MODEL ** -0.5),
        'moe_w2': nrm(ks[24], (n_moe, N_EXPERTS, D_FF_E, D_MODEL), D_FF_E ** -0.5 * BETA),
        'ln3_g': 1.0 + nrm(ks[25], (DEPTH, D_MODEL), 0.02),
        'ln3_b': nrm(ks[26], (DEPTH, D_MODEL), 0.02),
    }


def reference(x, mem, w_in, lam_q1, lam_k1, lam_q2, lam_k2, diff_norm_g, rel_bias, w_out,
              ln1_g, ln1_b, xattn_wq, xattn_wk, xattn_wv, xattn_wo, ln2_g, ln2_b,
              ffn_w1, ffn_w3, ffn_w2, moe_router, moe_w1, moe_w3, moe_w2, ln3_g, ln3_b):
    slopes_a, slopes_c = _alibi_slopes()
    h = x
    for l in range(DEPTH):
        mix = _hybrid_mixer(h, w_in[l], lam_q1[l], lam_k1[l], lam_q2[l], lam_k2[l],
                            diff_norm_g[l], rel_bias[l], w_out[l], l, slopes_a, slopes_c)
        h = _layer_norm(ALPHA * h + mix, ln1_g[l], ln1_b[l])
        xa = _mem_cross_attention(h, mem, xattn_wq[l], xattn_wk[l], xattn_wv[l], xattn_wo[l])
        h = _layer_norm(ALPHA * h + xa, ln2_g[l], ln2_b[l])
        if l % 2 == 0:
            f = _swiglu(h, ffn_w1[l // 2], ffn_w3[l // 2], ffn_w2[l // 2])
        else:
            f = _moe(h, moe_router[l // 2], moe_w1[l // 2], moe_w3[l // 2], moe_w2[l // 2])
        h = _layer_norm(ALPHA * h + f, ln3_g[l], ln3_b[l])
    return h
```

```cpp
#include <hip/hip_runtime.h>
#include <stdint.h>
#include <stdio.h>
#define MK_ONE_LAUNCH 1
#define MK_DUP_PH 0
#define MK_DUP_N 0
#define MK_DUP_SUB 0

typedef uint16_t bf16_t;
#define LAS __attribute__((address_space(3)))
#define GAS __attribute__((address_space(1)))

constexpr int D = 1024, NB = 8, S = 4096, T = NB * S, NMEM = 256;
constexpr int NIN = 3656, NINP = 3840;
constexpr int OFF_QA = 0, OFF_KA = 512, OFF_VA = 1024, OFF_QB = 1536, OFF_KB = 1792, OFF_VB = 2048;
constexpr int OFF_QC = 2304, OFF_KC = 2560, OFF_VC = 2816, OFF_QI = 3072, OFF_KI = 3584, OFF_WI = 3648;
constexpr int DFF = 2816, NE = 8, DFFE = 3584;
constexpr float ALPHA = 1.41421356237f;
constexpr float LN_EPS = 1e-5f, RMS_EPS = 1e-6f;
constexpr float LOG2E = 1.4426950408889634f;
constexpr int MAXROWS = 2 * T + NE * 256;
constexpr int PASS_TILES = MAXROWS / 256 / 2;
constexpr int PASS_ROWS = PASS_TILES * 256;

constexpr size_t MiB = 1u << 20;
constexpr size_t WS_CTL = 0;
constexpr size_t WS_WSM = 2 * MiB;
constexpr size_t WS_WBIG = 20 * MiB;
constexpr size_t WS_BIG = 188 * MiB;
constexpr size_t WS_ZB = WS_BIG + 176 * MiB;
constexpr size_t WS_B0 = 428 * MiB;
constexpr size_t WS_B1 = 492 * MiB;
constexpr size_t WS_XG = WS_B0;
constexpr size_t WS_KV = 560 * MiB;
constexpr size_t WS_MEMB = 568 * MiB;
constexpr size_t WS_END = 572 * MiB;
constexpr size_t WSM_WIN = 0, WSM_WOUT = (size_t)NINP * D, WSM_WQ = WSM_WOUT + (size_t)D * D, WSM_WO = WSM_WQ + (size_t)D * D, WSM_WKV = WSM_WO + (size_t)D * D;
static_assert((WSM_WKV + 2 * (size_t)D * D) * 2 <= 18 * MiB, "wsm");
constexpr size_t ISC_BATCH = (size_t)4096 * 2080;
constexpr int ISC_IN_WBIG = 5;
constexpr size_t OUT_MASK = (size_t)3 * ISC_BATCH * 4;
static_assert((size_t)ISC_IN_WBIG * ISC_BATCH * 4 <= 168 * MiB && OUT_MASK + (size_t)T * 512 <= (size_t)T * D * 4, "isc scratch");
constexpr size_t CT_BAR = 0;
constexpr size_t CT_CNT = 32 * 1024;
constexpr size_t CT_QCTR = 36 * 1024;
constexpr size_t CT_NORM = 108 * 1024;
constexpr size_t CT_LAM = 64 * 1024;
constexpr size_t CT_TILEE = 66 * 1024;
constexpr size_t CT_E0 = 128 * 1024;
constexpr size_t CT_E1 = CT_E0 + T * 4;
constexpr size_t CT_G0 = CT_E1 + T * 4;
constexpr size_t CT_G1 = CT_G0 + T * 4;
constexpr size_t CT_P0 = CT_G1 + T * 4;
constexpr size_t CT_P1 = CT_P0 + T * 4;
constexpr size_t CT_ROWTOK = CT_P1 + T * 4;
static_assert(CT_ROWTOK + MAXROWS * 4 <= 2 * MiB, "ctl");
constexpr size_t CTL_ZERO_BYTES = 64 * 1024;

constexpr int LDS_BYTES = 147456;
constexpr int LDS_MISC = 131072;

struct Params {
    const float *x, *mem, *w_in, *lq1, *lk1, *lq2, *lk2, *dgain, *relb, *w_out, *ln1g, *ln1b, *wq, *wk, *wv, *wo, *ln2g, *ln2b,
        *fw1, *fw3, *fw2, *router, *mw1, *mw3, *mw2, *ln3g, *ln3b;
    float* out;
    unsigned char* ws;
    int ph_lo, ph_hi;
    int sub, pad_;
};

typedef const __attribute__((address_space(4))) Params CParams;
__device__ __forceinline__ CParams* opqk(CParams* x) { asm volatile("" : "+s"(x)); return x; }
typedef float f32x4 __attribute__((ext_vector_type(4)));
typedef unsigned u32x4 __attribute__((ext_vector_type(4)));
typedef unsigned u32x2 __attribute__((ext_vector_type(2)));

__device__ __forceinline__ float bf2f(bf16_t v) { return __uint_as_float(((unsigned)v) << 16); }
__device__ __forceinline__ bf16_t f2bf(float f) { unsigned u = __float_as_uint(f); return (bf16_t)((u + 0x7fffu + ((u >> 16) & 1u)) >> 16); }
__device__ __forceinline__ unsigned pk2(float lo, float hi) { typedef float f2 __attribute__((ext_vector_type(2))); typedef __bf16 b2 __attribute__((ext_vector_type(2)));
    f2 v = {lo, hi}; b2 b = __builtin_convertvector(v, b2); return __builtin_bit_cast(unsigned, b); }
__device__ __forceinline__ float ldA(const float* p) { return *p; }
__device__ __forceinline__ float ldA(const bf16_t* p) { return bf2f(*p); }
__device__ __forceinline__ float wave_max(float v) { for (int o = 32; o > 0; o >>= 1) v = fmaxf(v, __shfl_xor(v, o)); return v; }
__device__ __forceinline__ float wave_sum(float v) { for (int o = 32; o > 0; o >>= 1) v += __shfl_xor(v, o); return v; }

__device__ __forceinline__ int tid_of(int wids) { int t = (wids << 6) | (int)__builtin_amdgcn_mbcnt_hi(~0u, __builtin_amdgcn_mbcnt_lo(~0u, 0u)); asm volatile("" : "+v"(t)); return t; }
#define TIDX tid_of(WIDS)

__device__ __forceinline__ unsigned char* opq(unsigned char* x) { asm volatile("" : "+s"(x)); return x; }
template <typename T_> __device__ __forceinline__ T_* asg(T_* x) { return x; }
#define WSX asg(opq(p.ws))

__device__ __forceinline__ int opq_i(int x) { asm volatile("" : "+s"(x)); return x; }
#define BIDX opq_i((int)blockIdx.x)
#define GDIM opq_i((int)gridDim.x)

namespace pg8 {
#define PG8_LAS __attribute__((address_space(3)))
typedef unsigned short bf16_t;
typedef short bf16x8 __attribute__((ext_vector_type(8)));
typedef float f32x4 __attribute__((ext_vector_type(4)));
typedef unsigned u32x4 __attribute__((ext_vector_type(4)));
constexpr int BM = 256, BK = 64, HALF = 128, HTB = HALF * BK * 2  , STAGE_BYTES = 8 * HTB, NXCD = 8, WGM = 8;

__host__ __device__ __forceinline__ int lds_byte(int r, int c) { const int st = (r >> 4) * 2 + (c >> 5), rr = r & 15, cc = c & 31, ob = rr * 64 + cc * 2; return st * 1024 + (ob ^ (((ob >> 9) & 1) << 5)); }
__host__ __device__ __forceinline__ void stage_rc(int b, int& R, int& C) { const int st = b / 1024, sb = b % 1024, swz = sb ^ (((sb >> 9) & 1) << 5); R = (st >> 1) * 16 + swz / 64; C = (st & 1) * 32 + (swz % 64) / 2; }
__host__ __device__ __forceinline__ int perm32(int rho) { const int n = rho >> 4, i = rho & 15; return 8 * (i >> 2) + 4 * n + (i & 3); }

struct Unit { int pm, pn; };
struct Gemm { const bf16_t* A; const bf16_t* Bt; int M, N, K; };

struct StaticOrder {
    int nM, nN, nwg, G, c;
    __host__ __device__ void init(int M, int N, int G_, int c_) { nM = M / BM; nN = N / BM; nwg = nM * nN; G = G_; c = c_; }
    __host__ __device__ __forceinline__ bool next(int i, Unit& u) const {
        const long L = (long)i * G + c; if (L >= nwg) return false;
        int wgid = (int)L; { const int q = nwg / NXCD, r = nwg % NXCD, xcd = wgid % NXCD, off = wgid / NXCD; wgid = (xcd < r ? xcd * (q + 1) : r * (q + 1) + (xcd - r) * q) + off; }
        const int nig = WGM * nN, gid = wgid / nig, fm = gid * WGM, gsz = (nM - fm) < WGM ? (nM - fm) : WGM;
        u.pm = fm + ((wgid % nig) % gsz); u.pn = (wgid % nig) / gsz; return true;
    }
    __device__ __forceinline__ void a_ready(const Unit&) const {}
    __device__ __forceinline__ void done(const Unit&) const {}
};


struct MoeOrder {
    const int* tile_e; int nvalid, nN, G, c;
    __device__ bool next(int i, Unit& u) const {
        const long L = (long)i * G + c; if (L >= (long)nvalid * nN) return false;
        const int pm = (int)(L / nN), pn = (int)(L % nN); const int e = __builtin_amdgcn_readfirstlane(tile_e[pm]);
        u.pm = pm; u.pn = e * nN + pn; return true;
    }
    __device__ __forceinline__ void a_ready(const Unit&) const {}
    __device__ __forceinline__ void done(const Unit&) const {}
};
struct EpiStore {
    static constexpr bool PERM = true, AFTER_DRAIN = false;
    bf16_t* O; int ldc; int nN;
    __device__ __forceinline__ void operator()(const f32x4 (&acc)[2][2][4][2], const Unit& u, int wr, int wc, int fr, int fq) const {
        const int row0 = u.pm * BM + wr * 64 + fr; const int pn = nN ? (u.pn % nN) : u.pn; const int col0 = pn * BM + wc * 32 + 8 * fq;
#pragma unroll
        for (int ai = 0; ai < 2; ++ai)
#pragma unroll
            for (int m = 0; m < 4; ++m) { bf16_t* rowp = O + (size_t)(row0 + ai * HALF + m * 16) * ldc + col0;
#pragma unroll
                for (int bj = 0; bj < 2; ++bj) { const f32x4 v0 = acc[ai][bj][m][0], v1 = acc[ai][bj][m][1];
                    u32x4 w; w.x = ::pk2(v0[0], v0[1]); w.y = ::pk2(v0[2], v0[3]); w.z = ::pk2(v1[0], v1[1]); w.w = ::pk2(v1[2], v1[3]);
                    *(u32x4*)(rowp + bj * HALF) = w; } }
    }
};
struct ProjKvOrder {
    StaticOrder so; int nproj, ng, cc, kv_pm0, kv_pn0;
    __device__ void init(int M, int N, int g_, int c_, int pm0, int pn0) { so.init(M, N, g_, c_); nproj = (M / BM) * (N / BM); ng = g_; cc = c_; kv_pm0 = pm0; kv_pn0 = pn0; }
    __device__ bool next(int i, Unit& u) const {
        const long L = (long)i * ng + cc;
        if (L < nproj) return so.next(i, u);
        const int r = (int)(L - nproj); if (r >= 64) return false;
        u.pm = kv_pm0 + (r >> 3); u.pn = kv_pn0 + (r & 7); return true;
    }
    __device__ __forceinline__ void a_ready(const Unit&) const {}
    __device__ __forceinline__ void done(const Unit&) const {}
};
struct EpiProjKv {
    static constexpr bool PERM = true, AFTER_DRAIN = false;
    bf16_t* O; int ldc; bf16_t* O2; int kv_pm0, kv_pn0;
    __device__ __forceinline__ void operator()(const f32x4 (&acc)[2][2][4][2], const Unit& u, int wr, int wc, int fr, int fq) const {
        const bool kv = u.pm >= kv_pm0;
        bf16_t* base = kv ? O2 : O; const int ld = kv ? 2048 : ldc; const int pm = kv ? u.pm - kv_pm0 : u.pm, pn = kv ? u.pn - kv_pn0 : u.pn;
        const int row0 = pm * BM + wr * 64 + fr, col0 = pn * BM + wc * 32 + 8 * fq;
#pragma unroll
        for (int ai = 0; ai < 2; ++ai)
#pragma unroll
            for (int m = 0; m < 4; ++m) { bf16_t* rowp = base + (size_t)(row0 + ai * HALF + m * 16) * ld + col0;
#pragma unroll
                for (int bj = 0; bj < 2; ++bj) { const f32x4 v0 = acc[ai][bj][m][0], v1 = acc[ai][bj][m][1];
                    u32x4 w; w.x = ::pk2(v0[0], v0[1]); w.y = ::pk2(v0[2], v0[3]); w.z = ::pk2(v1[0], v1[1]); w.w = ::pk2(v1[2], v1[3]);
                    *(u32x4*)(rowp + bj * HALF) = w; } }
    }
};
struct EpiResid {
    static constexpr bool PERM = true, AFTER_DRAIN = false;
    const bf16_t* resid; bf16_t* out;
    __device__ __forceinline__ void operator()(const f32x4 (&acc)[2][2][4][2], const Unit& u, int wr, int wc, int fr, int fq) const {
        const int row0 = u.pm * BM + wr * 64 + fr, col0 = u.pn * BM + wc * 32 + 8 * fq;
#pragma unroll
        for (int ai = 0; ai < 2; ++ai)
#pragma unroll
            for (int m = 0; m < 4; ++m) { const size_t off = (size_t)(row0 + ai * HALF + m * 16) * 1024 + col0;
#pragma unroll
                for (int bj = 0; bj < 2; ++bj) { const size_t o = off + bj * HALF; const u32x4 rb = *(const u32x4*)(resid + o);
                    const f32x4 v0 = acc[ai][bj][m][0], v1 = acc[ai][bj][m][1]; const float A = 1.41421356237f;
                    u32x4 w;
                    w.x = ::pk2(__uint_as_float(rb.x << 16) * A + v0[0], __uint_as_float(rb.x & 0xffff0000u) * A + v0[1]);
                    w.y = ::pk2(__uint_as_float(rb.y << 16) * A + v0[2], __uint_as_float(rb.y & 0xffff0000u) * A + v0[3]);
                    w.z = ::pk2(__uint_as_float(rb.z << 16) * A + v1[0], __uint_as_float(rb.z & 0xffff0000u) * A + v1[1]);
                    w.w = ::pk2(__uint_as_float(rb.w << 16) * A + v1[2], __uint_as_float(rb.w & 0xffff0000u) * A + v1[3]);
                    *(u32x4*)(out + o) = w; } }
    }
};
struct EpiSwiglu {
    static constexpr bool PERM = true, AFTER_DRAIN = false;
    bf16_t* O; int ldc; int nN;
    static __device__ __forceinline__ float sg(float g, float u) { return g * __builtin_amdgcn_rcpf(1.0f + __builtin_amdgcn_exp2f(-1.4426950408889634f * g)) * u; }
    __device__ __forceinline__ void operator()(const f32x4 (&acc)[2][2][4][2], const Unit& u, int wr, int wc, int fr, int fq) const {
        const int row0 = u.pm * BM + wr * 64 + fr; const int pn = nN ? (u.pn % nN) : u.pn; const int col0 = pn * HALF + wc * 32 + 8 * fq;
#pragma unroll
        for (int ai = 0; ai < 2; ++ai)
#pragma unroll
            for (int m = 0; m < 4; ++m) { bf16_t* rowp = O + (size_t)(row0 + ai * HALF + m * 16) * ldc + col0;
                const f32x4 g0 = acc[ai][0][m][0], g1 = acc[ai][0][m][1], u0 = acc[ai][1][m][0], u1 = acc[ai][1][m][1];
                u32x4 w; w.x = ::pk2(sg(g0[0], u0[0]), sg(g0[1], u0[1])); w.y = ::pk2(sg(g0[2], u0[2]), sg(g0[3], u0[3]));
                w.z = ::pk2(sg(g1[0], u1[0]), sg(g1[1], u1[1])); w.w = ::pk2(sg(g1[2], u1[2]), sg(g1[3], u1[3]));
                *(u32x4*)rowp = w; }
    }
};

template <class Epi, class Sched, bool ALIGN_EPI = false, bool SP2 = false>
__device__ __forceinline__ void gemm_phase(PG8_LAS unsigned char* lds, const Gemm g, const Sched& S, const Epi& E, int WIDS) {
    int tid_ = ::tid_of(WIDS); asm volatile("" : "+v"(tid_));
    const int tid = tid_, wid = __builtin_amdgcn_readfirstlane(tid >> 6), lane = tid & 63, wr = wid >> 2, wc = wid & 3, fr = lane & 15, fq = lane >> 4;
    const int K = g.K, nt = K / BK;
    unsigned voffA[2], voffB[2];
#pragma unroll
    for (int i = 0; i < 2; ++i) { int R, C; stage_rc(tid * 16 + i * 8192, R, C); const int Rb = Epi::PERM ? ((R & ~31) + perm32(R & 31)) : R;
        voffA[i] = (unsigned)(R * K + C) * 2u; voffB[i] = (unsigned)(Rb * K + C) * 2u; }
    const size_t kstep = (size_t)(BK * 2);
    const size_t hstep = (size_t)HALF * K * 2;
    const size_t tstep = 2 * hstep;
    const unsigned ldsw = (unsigned)wid * 1024u;
    const int aoff = lds_byte(wr * 64 + fr, fq * 8), boff = lds_byte(wc * 32 + fr, fq * 8);
#define PG8_SA(b, h) (((b) * 2 + (h)) * HTB)
#define PG8_SB(b, h) ((4 + (b) * 2 + (h)) * HTB)
#define PG8_STAGE(bufoff, gbase, voff) do { _Pragma("unroll") for (int _i = 0; _i < 2; ++_i) \
        __builtin_amdgcn_global_load_lds((const unsigned*)((const char*)(gbase) + (voff)[_i]), (PG8_LAS unsigned*)(lds + (bufoff) + ldsw + _i * 8192), 16, 0, 0); } while (0)
#define PG8_LDA(dst, b, h) do { _Pragma("unroll") for (int m = 0; m < 4; ++m) _Pragma("unroll") for (int k = 0; k < 2; ++k) dst[m][k] = *(const PG8_LAS bf16x8*)(lds + PG8_SA(b, h) + aoff + m * 2048 + k * 1024); } while (0)
#define PG8_LDB(dst, b, h) do { _Pragma("unroll") for (int n = 0; n < 2; ++n) _Pragma("unroll") for (int k = 0; k < 2; ++k) dst[n][k] = *(const PG8_LAS bf16x8*)(lds + PG8_SB(b, h) + boff + n * 2048 + k * 1024); } while (0)
#define PG8_MMA(ai, bj, At, Bt) do { __builtin_amdgcn_s_setprio(1); _Pragma("unroll") for (int m = 0; m < 4; ++m) _Pragma("unroll") for (int n = 0; n < 2; ++n) _Pragma("unroll") for (int k = 0; k < 2; ++k) \
        acc[ai][bj][m][n] = __builtin_amdgcn_mfma_f32_16x16x32_bf16(Bt[n][k], At[m][k], acc[ai][bj][m][n], 0, 0, 0); __builtin_amdgcn_s_setprio(0); } while (0)
#define PG8_WAIT_V(n) asm volatile("s_waitcnt vmcnt(" #n ")" ::: "memory")
#define PG8_WAIT_L(n) asm volatile("s_waitcnt lgkmcnt(" #n ")" ::: "memory")
#define PG8_BAR __builtin_amdgcn_s_barrier()
#define PG8_SCHED __builtin_amdgcn_sched_barrier(0)
    Unit cur, nxt; int ui = 0;
    if (!S.next(0, cur)) return;
    f32x4 acc[2][2][4][2];
#pragma unroll
    for (int a = 0; a < 2; ++a)
#pragma unroll
        for (int b = 0; b < 2; ++b)
#pragma unroll
            for (int m = 0; m < 4; ++m)
#pragma unroll
                for (int n = 0; n < 2; ++n) acc[a][b][m][n] = (f32x4){0.f, 0.f, 0.f, 0.f};
    bf16x8 At[4][2], B0[2][2], B1[2][2];
    const char* cA = (const char*)g.A + (size_t)cur.pm * tstep; const char* cB = (const char*)g.Bt + (size_t)cur.pn * tstep;
    S.a_ready(cur);
    if constexpr (SP2) {
        PG8_STAGE(PG8_SB(0, 0), cB, voffB); PG8_STAGE(PG8_SB(0, 1), cB + hstep, voffB); PG8_STAGE(PG8_SA(0, 0), cA, voffA); PG8_STAGE(PG8_SA(0, 1), cA + hstep, voffA);
        if (wr == 1) PG8_BAR;
        PG8_WAIT_V(2); PG8_BAR;
        PG8_STAGE(PG8_SB(1, 0), cB + kstep, voffB); PG8_STAGE(PG8_SA(1, 0), cA + kstep, voffA); PG8_STAGE(PG8_SB(1, 1), cB + hstep + kstep, voffB);
        PG8_WAIT_V(6); PG8_BAR;
    } else {
        PG8_STAGE(PG8_SB(0, 0), cB, voffB); PG8_STAGE(PG8_SA(0, 0), cA, voffA); PG8_STAGE(PG8_SB(0, 1), cB + hstep, voffB); PG8_STAGE(PG8_SA(0, 1), cA + hstep, voffA);
        if (wr == 1) PG8_BAR;
        PG8_WAIT_V(4); PG8_BAR;
        PG8_STAGE(PG8_SB(1, 0), cB + kstep, voffB); PG8_STAGE(PG8_SA(1, 0), cA + kstep, voffA); PG8_STAGE(PG8_SB(1, 1), cB + hstep + kstep, voffB);
        PG8_WAIT_V(6); PG8_BAR;
    }
    for (;;) {
        const bool has_next = S.next(ui + 1, nxt);
        const char* nA = has_next ? (const char*)g.A + (size_t)nxt.pm * tstep : cA; const char* nB = has_next ? (const char*)g.Bt + (size_t)nxt.pn * tstep : cB;
        for (int t = 0; t < nt; t += 2) {
            const bool last = (t == nt - 2);
            const char* a1 = cA + (size_t)(t + 1) * kstep;
            const char* a2 = last ? nA : cA + (size_t)(t + 2) * kstep; const char* b2 = last ? nB : cB + (size_t)(t + 2) * kstep;
            const char* a3 = a2 + kstep; const char* b3 = b2 + kstep;
            if (last && has_next) S.a_ready(nxt);
            if constexpr (SP2) {
            PG8_LDB(B0, 0, 0); PG8_LDB(B1, 0, 1); PG8_SCHED; PG8_LDA(At, 0, 0); PG8_STAGE(PG8_SA(1, 1), a1 + hstep, voffA);
            PG8_WAIT_V(8); PG8_WAIT_L(0); PG8_BAR; PG8_MMA(0, 0, At, B0); PG8_MMA(0, 1, At, B1); PG8_BAR; PG8_SCHED;
            PG8_LDA(At, 0, 1); PG8_STAGE(PG8_SB(0, 0), b2, voffB); PG8_STAGE(PG8_SB(0, 1), b2 + hstep, voffB); PG8_STAGE(PG8_SA(0, 0), a2, voffA);
            PG8_WAIT_V(8); PG8_WAIT_L(0); PG8_BAR; PG8_MMA(1, 0, At, B0); PG8_MMA(1, 1, At, B1); PG8_BAR; PG8_SCHED;
            PG8_LDB(B0, 1, 0); PG8_LDB(B1, 1, 1); PG8_SCHED; PG8_LDA(At, 1, 0); PG8_STAGE(PG8_SA(0, 1), a2 + hstep, voffA);
            PG8_WAIT_V(8); PG8_WAIT_L(0); PG8_BAR; PG8_MMA(0, 0, At, B0); PG8_MMA(0, 1, At, B1); PG8_BAR; PG8_SCHED;
            PG8_LDA(At, 1, 1); PG8_STAGE(PG8_SB(1, 0), b3, voffB); PG8_STAGE(PG8_SB(1, 1), b3 + hstep, voffB); PG8_STAGE(PG8_SA(1, 0), a3, voffA);
            PG8_WAIT_V(8); PG8_WAIT_L(0); PG8_BAR; PG8_MMA(1, 0, At, B0); PG8_MMA(1, 1, At, B1); PG8_BAR; PG8_SCHED;
            } else {
            PG8_LDB(B0, 0, 0); PG8_SCHED; PG8_LDA(At, 0, 0); PG8_STAGE(PG8_SA(1, 1), a1 + hstep, voffA);
            PG8_WAIT_L(8); PG8_BAR; PG8_WAIT_L(0); PG8_MMA(0, 0, At, B0); PG8_BAR; PG8_SCHED;
            PG8_LDB(B1, 0, 1); PG8_STAGE(PG8_SB(0, 0), b2, voffB);
            PG8_BAR; PG8_WAIT_L(0); PG8_MMA(0, 1, At, B1); PG8_BAR;
            PG8_LDA(At, 0, 1); PG8_STAGE(PG8_SA(0, 0), a2, voffA);
            PG8_BAR; PG8_WAIT_L(0); PG8_MMA(1, 0, At, B0); PG8_BAR; PG8_SCHED;
            PG8_STAGE(PG8_SB(0, 1), b2 + hstep, voffB);
            PG8_WAIT_V(6); PG8_BAR; PG8_MMA(1, 1, At, B1); PG8_BAR;
            PG8_LDB(B0, 1, 0); PG8_SCHED; PG8_LDA(At, 1, 0); PG8_STAGE(PG8_SA(0, 1), a2 + hstep, voffA);
            PG8_WAIT_L(8); PG8_BAR; PG8_WAIT_L(0); PG8_MMA(0, 0, At, B0); PG8_BAR; PG8_SCHED;
            PG8_LDB(B1, 1, 1); PG8_STAGE(PG8_SB(1, 0), b3, voffB);
            PG8_BAR; PG8_WAIT_L(0); PG8_MMA(0, 1, At, B1); PG8_BAR;
            PG8_LDA(At, 1, 1); PG8_STAGE(PG8_SA(1, 0), a3, voffA);
            PG8_BAR; PG8_WAIT_L(0); PG8_MMA(1, 0, At, B0); PG8_BAR; PG8_SCHED;
            PG8_STAGE(PG8_SB(1, 1), b3 + hstep, voffB);
            PG8_WAIT_V(6); PG8_BAR; PG8_MMA(1, 1, At, B1); PG8_BAR;
            }
        }
        if constexpr (ALIGN_EPI) { if (wr == 0) PG8_BAR; }
        if constexpr (!Epi::AFTER_DRAIN) { E(acc, cur, wr, wc, fr, fq); S.done(cur); }
        if (!has_next) break;
#pragma unroll
        for (int a = 0; a < 2; ++a)
#pragma unroll
            for (int b = 0; b < 2; ++b)
#pragma unroll
                for (int m = 0; m < 4; ++m)
#pragma unroll
                    for (int n = 0; n < 2; ++n) acc[a][b][m][n] = (f32x4){0.f, 0.f, 0.f, 0.f};
        cur = nxt; cA = nA; cB = nB; ++ui;
        if constexpr (ALIGN_EPI) { if (wr == 1) PG8_BAR; }
    }
    PG8_WAIT_V(0);
    if constexpr (!ALIGN_EPI) { if (wr == 0) PG8_BAR; }
    PG8_BAR;
    if constexpr (Epi::AFTER_DRAIN) { E.fused(acc, cur, wr, wc, fr, fq, lds, wid, lane); S.done(cur); }
#undef PG8_SA
#undef PG8_SB
#undef PG8_STAGE
#undef PG8_LDA
#undef PG8_LDB
#undef PG8_MMA
#undef PG8_WAIT_V
#undef PG8_WAIT_L
#undef PG8_BAR
#undef PG8_SCHED
}
}

#define XB_TMO      128
#define XB_XCNT(j)  (256  + 64 * (j))
#define XB_XSUB(j)  (1280 + 64 * (j))
#define XB_XGEN(j)  (2304 + 64 * (j))
#define XB_TOP      3328
#define XB_TOPGEN   3392
#define XCD_BAR_WORDS 3456
#define XB_SPIN_CAP (1u << 18)

__device__ __forceinline__ unsigned xb_ld(unsigned* p)              { return __hip_atomic_load(p, __ATOMIC_RELAXED, __HIP_MEMORY_SCOPE_AGENT); }
__device__ __forceinline__ unsigned xb_add(unsigned* p, unsigned v) { return __hip_atomic_fetch_add(p, v, __ATOMIC_RELAXED, __HIP_MEMORY_SCOPE_AGENT); }
__device__ __forceinline__ unsigned xb_xcc_id() { return (unsigned)__builtin_amdgcn_s_getreg((3 << 11) | 20) & 0xFu; }
#define XB_SPIN(cond, bar) do { unsigned _sp = 0; while (cond) { __builtin_amdgcn_s_sleep(1); \
    if ((++_sp & 255u) == 0u) { if (xb_ld(&(bar)[XB_TMO])) break; if (_sp > XB_SPIN_CAP) { atomicAdd(&(bar)[XB_TMO], 1u); break; } } } } while (0)

struct XcdBarrier {
    unsigned* bar; unsigned x;
    volatile LAS unsigned* st;
};

__device__ __forceinline__ XcdBarrier xcd_barrier_post(unsigned* bar, volatile LAS unsigned* st, int WIDS) {
    XcdBarrier b; b.bar = bar; b.x = xb_xcc_id(); b.st = st;
    if (tid_of(WIDS) == 0) (void)xb_add(&bar[XB_XCNT(b.x)], 1u);
    return b;
}
__device__ __forceinline__ void xcd_barrier_complete(unsigned* bar, unsigned x, unsigned& nloc, unsigned& nx) {
    const unsigned G = gridDim.x * gridDim.y * gridDim.z;
    unsigned sum, cnt, mine, sp = 0u;
    for (;;) {
        sum = 0u; cnt = 0u; mine = 0u;
#pragma unroll
        for (unsigned j = 0; j < 16; ++j) { const unsigned c = xb_ld(&bar[XB_XCNT(j)]); sum += c; cnt += (c > 0u) ? 1u : 0u; mine = (j == x) ? c : mine; }
        if (sum == G) break;
        __builtin_amdgcn_s_sleep(1);
        if ((++sp & 255u) == 0u) { if (xb_ld(&bar[XB_TMO])) break; if (sp > XB_SPIN_CAP) { atomicAdd(&bar[XB_TMO], 1u); break; } }
    }
    nloc = mine > 0u ? mine : 1u; nx = cnt > 0u ? cnt : 1u;
}

__device__ __forceinline__ void xcd_barrier(const XcdBarrier& b, int WIDS) {
    asm volatile("s_waitcnt vmcnt(0)" ::: "memory");
    __syncthreads();
    if (tid_of(WIDS) == 0) {
        unsigned* bar = b.bar;
        __builtin_amdgcn_s_waitcnt(0);
        unsigned nloc = b.st[0], nx = b.st[1];
        if (nloc == 0u) { xcd_barrier_complete(bar, b.x, nloc, nx); b.st[0] = nloc; b.st[1] = nx; }
        const unsigned old = xb_add(&bar[XB_XSUB(b.x)], 1u);
        const unsigned gen = old / nloc;
        if (old + 1u == (gen + 1u) * nloc) {
            __builtin_amdgcn_fence(__ATOMIC_RELEASE, "agent");
            asm volatile("s_waitcnt vmcnt(0)" ::: "memory");
            const unsigned og = xb_add(&bar[XB_TOP], 1u);
            const unsigned tg = og / nx;
            if (og + 1u == (tg + 1u) * nx) xb_add(&bar[XB_TOPGEN], 1u);
            else XB_SPIN(xb_ld(&bar[XB_TOPGEN]) == tg, bar);
            __builtin_amdgcn_fence(__ATOMIC_ACQUIRE, "agent");
            xb_add(&bar[XB_XGEN(b.x)], 1u);
            asm volatile("s_waitcnt vmcnt(0)" ::: "memory");
        } else {
            XB_SPIN(xb_ld(&bar[XB_XGEN(b.x)]) == gen, bar);
            __builtin_amdgcn_fence(__ATOMIC_ACQUIRE, "agent");
            asm volatile("s_waitcnt vmcnt(0)" ::: "memory");
        }
    }
    __syncthreads();
}

struct CvtJob { const float* src; bf16_t* dst; int K, N, Npad, G, gstride, off; };
__device__ __forceinline__ void cvt_job(const CvtJob j, float* tile  , int WIDS) {
    const int tid = TIDX, nkt = j.K / 64, nnt = j.Npad / 64;
    for (int item = BIDX; item < nkt * nnt; item += GDIM) {
        const int kt = item % nkt, nt = item / nkt, k0 = kt * 64, n0 = nt * 64;
        __syncthreads();
#pragma unroll
        for (int q = 0; q < 2; ++q) { const int k = (tid >> 4) + 32 * q, n = (tid & 15) * 4;
            f32x4 v = {0.f, 0.f, 0.f, 0.f}; if (n0 + n < j.N) v = *(const f32x4*)(j.src + (size_t)(k0 + k) * j.N + n0 + n);
            tile[k * 65 + n] = v[0]; tile[k * 65 + n + 1] = v[1]; tile[k * 65 + n + 2] = v[2]; tile[k * 65 + n + 3] = v[3]; }
        __syncthreads();
        const int n = tid >> 3, kc = (tid & 7) * 8, ng = n0 + n;
        u32x4 w; w.x = pk2(tile[(kc + 0) * 65 + n], tile[(kc + 1) * 65 + n]); w.y = pk2(tile[(kc + 2) * 65 + n], tile[(kc + 3) * 65 + n]);
        w.z = pk2(tile[(kc + 4) * 65 + n], tile[(kc + 5) * 65 + n]); w.w = pk2(tile[(kc + 6) * 65 + n], tile[(kc + 7) * 65 + n]);
        const size_t row = (size_t)(ng / j.G) * j.gstride + j.off + (ng % j.G);
        *(u32x4*)(j.dst + row * j.K + k0 + kc) = w;
    }
}
constexpr int GID = 1 << 30;

__device__ __forceinline__ void ph_prologue(CParams& p, int WIDS) {
    bf16_t* Hb = (bf16_t*)(WSX + WS_B0); bf16_t* Mb = (bf16_t*)(WSX + WS_MEMB);
    const size_t g = (size_t)BIDX * 512 + TIDX, gs = (size_t)GDIM * 512;
    for (size_t i = g; i < (size_t)T * D / 4; i += gs) { const f32x4 v = ((const f32x4*)asg(p.x))[i]; u32x2 w; w.x = pk2(v[0], v[1]); w.y = pk2(v[2], v[3]); ((u32x2*)Hb)[i] = w; }
    for (size_t i = g; i < (size_t)NB * NMEM * D / 4; i += gs) { const f32x4 v = ((const f32x4*)asg(p.mem))[i]; u32x2 w; w.x = pk2(v[0], v[1]); w.y = pk2(v[2], v[3]); ((u32x2*)Mb)[i] = w; }
    if (BIDX == 0 && TIDX < 2) {
        const int l = TIDX; float a = 0.f, b = 0.f;
        for (int i = 0; i < 64; ++i) { a += asg(p.lq1)[l * 64 + i] * asg(p.lk1)[l * 64 + i]; b += asg(p.lq2)[l * 64 + i] * asg(p.lk2)[l * 64 + i]; }
        const float lam_init = 0.8f - 0.6f * expf(-0.3f * (float)l);
        float* lam = (float*)(WSX + CT_LAM); lam[l * 2] = expf(a) - expf(b) + lam_init; lam[l * 2 + 1] = lam_init;
    }
}
__device__ __forceinline__ void ph_prep_small(CParams& p, int layer, float* lds, int WIDS) {
    bf16_t* W = (bf16_t*)(WSX + WS_WSM); const size_t DD = (size_t)D * D;
    cvt_job(CvtJob{asg(p.w_in) + (size_t)layer * D * NIN, W + WSM_WIN, D, NIN, NINP, GID, 0, 0}, lds, WIDS);
    cvt_job(CvtJob{asg(p.w_out) + layer * DD, W + WSM_WOUT, D, D, D, GID, 0, 0}, lds, WIDS);
    cvt_job(CvtJob{asg(p.wq) + layer * DD, W + WSM_WQ, D, D, D, GID, 0, 0}, lds, WIDS);
    cvt_job(CvtJob{asg(p.wo) + layer * DD, W + WSM_WO, D, D, D, GID, 0, 0}, lds, WIDS);
    cvt_job(CvtJob{asg(p.wk) + layer * DD, W + WSM_WKV, D, D, D, GID, 0, 0}, lds, WIDS);
    cvt_job(CvtJob{asg(p.wv) + layer * DD, W + WSM_WKV + DD, D, D, D, GID, 0, 0}, lds, WIDS);
}
constexpr size_t WB_W2 = (size_t)2 * DFF * D;
constexpr size_t WB_W2E = (size_t)NE * 2 * DFFE * D;
__device__ __forceinline__ void ph_prep_big(CParams& p, int layer, float* lds, int WIDS) {
    bf16_t* W = (bf16_t*)(WSX + WS_WBIG);
    if (layer == 0) {
        cvt_job(CvtJob{asg(p.fw1), W, D, DFF, DFF, 128, 256, 0}, lds, WIDS);
        cvt_job(CvtJob{asg(p.fw3), W, D, DFF, DFF, 128, 256, 128}, lds, WIDS);
        cvt_job(CvtJob{asg(p.fw2), W + WB_W2, DFF, D, D, GID, 0, 0}, lds, WIDS);
    } else {
        for (int e = 0; e < NE; ++e) {
            cvt_job(CvtJob{asg(p.mw1) + (size_t)e * D * DFFE, W + (size_t)e * 2 * DFFE * D, D, DFFE, DFFE, 128, 256, 0}, lds, WIDS);
            cvt_job(CvtJob{asg(p.mw3) + (size_t)e * D * DFFE, W + (size_t)e * 2 * DFFE * D, D, DFFE, DFFE, 128, 256, 128}, lds, WIDS);
            cvt_job(CvtJob{asg(p.mw2) + (size_t)e * DFFE * D, W + WB_W2E + (size_t)e * D * DFFE, DFFE, D, D, GID, 0, 0}, lds, WIDS);
        }
    }
}

__device__ __forceinline__ void ph_layernorm(CParams& p, const float* g, const float* b, int WIDS) {
    const bf16_t* X = (const bf16_t*)(WSX + WS_ZB); bf16_t* Hb = (bf16_t*)(WSX + WS_B0);
    const int lane = TIDX & 63, w = TIDX >> 6;
    f32x4 gv[4], bv[4];
#pragma unroll
    for (int j = 0; j < 4; ++j) { gv[j] = ((const f32x4*)g)[64 * j + lane]; bv[j] = ((const f32x4*)b)[64 * j + lane]; }
    for (int row = BIDX * 8 + w; row < T; row += GDIM * 8) {
        const u32x2* xr = (const u32x2*)(X + (size_t)row * D) + lane; f32x4 v[4]; float s = 0.f;
#pragma unroll
        for (int j = 0; j < 4; ++j) { const u32x2 z = xr[64 * j]; v[j] = (f32x4){__uint_as_float(z.x << 16), __uint_as_float(z.x & 0xffff0000u), __uint_as_float(z.y << 16), __uint_as_float(z.y & 0xffff0000u)}; s += (v[j][0] + v[j][1]) + (v[j][2] + v[j][3]); }
        const float mu = wave_sum(s) * (1.0f / D); float q = 0.f;
#pragma unroll
        for (int j = 0; j < 4; ++j) { v[j] = v[j] - mu; q += (v[j][0] * v[j][0] + v[j][1] * v[j][1]) + (v[j][2] * v[j][2] + v[j][3] * v[j][3]); }
        const float rstd = rsqrtf(wave_sum(q) * (1.0f / D) + LN_EPS);
        u32x2* hb = (u32x2*)(Hb + (size_t)row * D) + lane;
#pragma unroll
        for (int j = 0; j < 4; ++j) { const f32x4 y = v[j] * rstd * gv[j] + bv[j]; u32x2 w2; w2.x = pk2(y[0], y[1]); w2.y = pk2(y[2], y[3]); hb[64 * j] = w2; }
    }
}
constexpr size_t CT_BLKCNT = 96 * 1024;
__device__ __forceinline__ void ph_ln_router(CParams& p, const float* g, const float* b, LAS unsigned char* lds, int WIDS) {
    float* X = asg(p.out); const bf16_t* Z = (const bf16_t*)(WSX + WS_ZB); const int tid = TIDX, lane = tid & 63, w = tid >> 6, bid = BIDX, G = GDIM, TPB = (T + G - 1) / G;
    int* e0 = (int*)(WSX + CT_E0); int* e1 = (int*)(WSX + CT_E1); float* g0 = (float*)(WSX + CT_G0); float* g1 = (float*)(WSX + CT_G1);
    LAS float* R = (LAS float*)lds;
    LAS int* lc = (LAS int*)(lds + 32768);
    __syncthreads();
    for (int i = tid; i < 8 * D; i += 512) R[(i & 7) * D + (i >> 3)] = asg(p.router)[i];
    if (tid < 8) lc[tid] = 0;
    __syncthreads();
    f32x4 gv[4], bv[4];
#pragma unroll
    for (int j = 0; j < 4; ++j) { gv[j] = ((const f32x4*)g)[64 * j + lane]; bv[j] = ((const f32x4*)b)[64 * j + lane]; }
    for (int tl = w; tl < TPB; tl += 8) {
        const int row = bid * TPB + tl; if (row >= T) break;
        f32x4* xr = (f32x4*)(X + (size_t)row * D) + lane; const u32x2* zr = (const u32x2*)(Z + (size_t)row * D) + lane; f32x4 v[4]; float s = 0.f;
#pragma unroll
        for (int j = 0; j < 4; ++j) { const u32x2 z = zr[64 * j]; v[j] = (f32x4){__uint_as_float(z.x << 16), __uint_as_float(z.x & 0xffff0000u), __uint_as_float(z.y << 16), __uint_as_float(z.y & 0xffff0000u)}; s += (v[j][0] + v[j][1]) + (v[j][2] + v[j][3]); }
        const float mu = wave_sum(s) * (1.0f / D); float q = 0.f;
#pragma unroll
        for (int j = 0; j < 4; ++j) { v[j] = v[j] - mu; q += (v[j][0] * v[j][0] + v[j][1] * v[j][1]) + (v[j][2] * v[j][2] + v[j][3] * v[j][3]); }
        const float rstd = rsqrtf(wave_sum(q) * (1.0f / D) + LN_EPS);
#pragma unroll
        for (int j = 0; j < 4; ++j) { v[j] = v[j] * rstd * gv[j] + bv[j]; xr[64 * j] = v[j]; }
        float lg[8];
#pragma unroll
        for (int e = 0; e < 8; ++e) { float a = 0.f;
#pragma unroll
            for (int j = 0; j < 4; ++j) { const f32x4 r = *(const LAS f32x4*)(R + e * D + 256 * j + 4 * lane); a += (v[j][0] * r[0] + v[j][1] * r[1]) + (v[j][2] * r[2] + v[j][3] * r[3]); }
            lg[e] = wave_sum(a); }
        if (lane == 0) {
            int i0 = 0; float b0 = lg[0];
#pragma unroll
            for (int e = 1; e < 8; ++e) if (lg[e] > b0) { b0 = lg[e]; i0 = e; }
            int i1 = -1; float b1 = -INFINITY;
#pragma unroll
            for (int e = 0; e < 8; ++e) if (e != i0 && lg[e] > b1) { b1 = lg[e]; i1 = e; }
            const float a = 1.0f / (1.0f + expf(b1 - b0));
            e0[row] = i0; e1[row] = i1; g0[row] = a; g1[row] = 1.0f - a;
            (void)__hip_atomic_fetch_add(lc + i0, 1, __ATOMIC_RELAXED, __HIP_MEMORY_SCOPE_WORKGROUP); (void)__hip_atomic_fetch_add(lc + i1, 1, __ATOMIC_RELAXED, __HIP_MEMORY_SCOPE_WORKGROUP);
        }
    }
    __syncthreads();
    if (tid < 8) ((int*)(WSX + CT_BLKCNT))[bid * 8 + tid] = lc[tid];
    __syncthreads();
}
__device__ __forceinline__ void ph_scatter(CParams& p, LAS unsigned char* lds, int WIDS) {
    const int tid = TIDX, lane = tid & 63, w = tid >> 6, bid = BIDX, G = GDIM, TPB = (T + G - 1) / G;
    const int* blk = (const int*)(WSX + CT_BLKCNT); int* cnt = (int*)(WSX + CT_CNT);
    LAS int* tot = (LAS int*)lds; LAS int* pre = tot + 8; LAS int* off = pre + 8;
    __syncthreads();
    { int t = 0, pb = 0; for (int bb = lane; bb < G; bb += 64) { const int c = blk[bb * 8 + w]; t += c; if (bb < bid) pb += c; }
#pragma unroll
      for (int o = 32; o > 0; o >>= 1) { t += __shfl_xor(t, o); pb += __shfl_xor(pb, o); }
      if (lane == 0) { tot[w] = t; pre[w] = pb; } }
    __syncthreads();
    if (tid == 0) { int o = 0; for (int e = 0; e < 8; ++e) { off[e] = o; o += ((tot[e] + 255) / 256) * 256; } off[8] = o; }
    __syncthreads();
    if (bid == 0) { int* tile_e = (int*)(WSX + CT_TILEE); if (tid < 8) cnt[tid] = tot[tid];
        for (int i = tid; i < MAXROWS / 256; i += 512) { int e = -1; for (int q = 0; q < 8; ++q) if (i * 256 >= off[q] && i * 256 < off[q + 1]) e = q; tile_e[i] = e; } }
    const int* e0 = (const int*)(WSX + CT_E0); const int* e1 = (const int*)(WSX + CT_E1);
    int* p0 = (int*)(WSX + CT_P0); int* p1 = (int*)(WSX + CT_P1);
    LAS int* posl = off + 16;
    int running = off[w] + pre[w];
    for (int n0 = 0; n0 < 2 * TPB; n0 += 64) {
        const int n = n0 + lane, tok = bid * TPB + (n >> 1), slot = n & 1;
        const bool ok = (n < 2 * TPB) && tok < T; const int e = ok ? (slot ? e1[tok] : e0[tok]) : -1;
        const unsigned long long m = __ballot(e == w);
        if (e == w) { const int pos = running + __popcll(m & ((1ull << lane) - 1ull)); if (slot) p1[tok] = pos; else p0[tok] = pos; posl[n] = pos; }
        running += __popcll(m);
    }
    __syncthreads();
    bf16_t* Xg = (bf16_t*)(WSX + WS_XG); const float* H = asg(p.out);
    for (int tl = w; tl < TPB; tl += 8) {
        const int tok = bid * TPB + tl; if (tok >= T) break;
        const f32x4* h = (const f32x4*)(H + (size_t)tok * D) + lane;
        u32x2* o0 = (u32x2*)(Xg + (size_t)posl[2 * tl] * D) + lane; u32x2* o1 = (u32x2*)(Xg + (size_t)posl[2 * tl + 1] * D) + lane;
#pragma unroll
        for (int j = 0; j < 4; ++j) { const f32x4 v = h[64 * j]; u32x2 w2; w2.x = pk2(v[0], v[1]); w2.y = pk2(v[2], v[3]); o0[64 * j] = w2; o1[64 * j] = w2; }
    }
    for (int e = 0; e < 8; ++e)
        for (int r = off[e] + tot[e] + bid * 8 + w; r < off[e + 1]; r += G * 8) { u32x2* o = (u32x2*)(Xg + (size_t)r * D) + lane;
#pragma unroll
            for (int j = 0; j < 4; ++j) { u32x2 z; z.x = 0u; z.y = 0u; o[64 * j] = z; } }
    __syncthreads();
}
__device__ __forceinline__ void ph_combine_ln(CParams& p, const float* g, const float* b, int WIDS) {
    const bf16_t* Yr = (const bf16_t*)(WSX + WS_XG); float* X = asg(p.out);
    const int* p0 = (const int*)(WSX + CT_P0); const int* p1 = (const int*)(WSX + CT_P1); const float* g0 = (const float*)(WSX + CT_G0); const float* g1 = (const float*)(WSX + CT_G1);
    const int lane = TIDX & 63, w = TIDX >> 6;
    f32x4 gv[4], bv[4];
#pragma unroll
    for (int j = 0; j < 4; ++j) { gv[j] = ((const f32x4*)g)[64 * j + lane]; bv[j] = ((const f32x4*)b)[64 * j + lane]; }
    for (int tok = BIDX * 8 + w; tok < T; tok += GDIM * 8) {
        const u32x2* ya = (const u32x2*)(Yr + (size_t)p0[tok] * D) + lane; const u32x2* yb = (const u32x2*)(Yr + (size_t)p1[tok] * D) + lane; const float ga = g0[tok], gb = g1[tok];
        f32x4* xr = (f32x4*)(X + (size_t)tok * D) + lane; f32x4 v[4]; float s = 0.f;
#pragma unroll
        for (int j = 0; j < 4; ++j) { const f32x4 h = xr[64 * j]; const u32x2 a = ya[64 * j], c = yb[64 * j];
            f32x4 fa = {__uint_as_float(a.x << 16), __uint_as_float(a.x & 0xffff0000u), __uint_as_float(a.y << 16), __uint_as_float(a.y & 0xffff0000u)};
            f32x4 fc = {__uint_as_float(c.x << 16), __uint_as_float(c.x & 0xffff0000u), __uint_as_float(c.y << 16), __uint_as_float(c.y & 0xffff0000u)};
            v[j] = h * ALPHA + fa * ga + fc * gb; s += (v[j][0] + v[j][1]) + (v[j][2] + v[j][3]); }
        const float mu = wave_sum(s) * (1.0f / D); float q = 0.f;
#pragma unroll
        for (int j = 0; j < 4; ++j) { v[j] = v[j] - mu; q += (v[j][0] * v[j][0] + v[j][1] * v[j][1]) + (v[j][2] * v[j][2] + v[j][3] * v[j][3]); }
        const float rstd = rsqrtf(wave_sum(q) * (1.0f / D) + LN_EPS);
#pragma unroll
        for (int j = 0; j < 4; ++j) xr[64 * j] = v[j] * rstd * gv[j] + bv[j];
    }
}

typedef short bf16x8 __attribute__((ext_vector_type(8)));
typedef short s16x4 __attribute__((ext_vector_type(4)));
typedef float f32x16 __attribute__((ext_vector_type(16)));
typedef short v4i16_t __attribute__((ext_vector_type(4)));
#define MFMA32(a, b, c) __builtin_amdgcn_mfma_f32_32x32x16_bf16((a), (b), (c), 0, 0, 0)
__device__ __forceinline__ s16x4 vtr(const LAS unsigned char* p) { return __builtin_bit_cast(s16x4, __builtin_amdgcn_ds_read_tr16_b64_v4i16((LAS v4i16_t*)p)); }
__device__ __forceinline__ bf16x8 pack8(float a0, float a1, float a2, float a3, float a4, float a5, float a6, float a7) {
    u32x4 w; w.x = pk2(a0, a1); w.y = pk2(a2, a3); w.z = pk2(a4, a5); w.w = pk2(a6, a7); return __builtin_bit_cast(bf16x8, w); }
__device__ __forceinline__ bf16x8 scale8(u32x4 q, float c) {
    return pack8(__uint_as_float(q.x << 16) * c, __uint_as_float(q.x & 0xffff0000u) * c, __uint_as_float(q.y << 16) * c, __uint_as_float(q.y & 0xffff0000u) * c,
                 __uint_as_float(q.z << 16) * c, __uint_as_float(q.z & 0xffff0000u) * c, __uint_as_float(q.w << 16) * c, __uint_as_float(q.w & 0xffff0000u) * c); }
__device__ __forceinline__ void wg_sync() { asm volatile("s_waitcnt vmcnt(0) lgkmcnt(0)" ::: "memory"); __builtin_amdgcn_s_barrier(); asm volatile("" ::: "memory"); }

__device__ __forceinline__ void glds16(const void* gsrc, unsigned lds_dst) { unsigned keep; const unsigned d = __builtin_amdgcn_readfirstlane(lds_dst);
    asm volatile("s_mov_b32 %0, m0\n\ts_mov_b32 m0, %2\n\ts_nop 0\n\tglobal_load_lds_dwordx4 %1, off\n\ts_mov_b32 m0, %0" : "=&s"(keep) : "v"(gsrc), "s"(d) : "memory"); }
template <int NKC, int NVB>
__device__ __forceinline__ void stage_tile(LAS unsigned char* buf, const bf16_t* ktile, int kpitch, const bf16_t* vtile, int vpitch, int wid, int lane) {
    constexpr int NP = NKC + 4 * NVB;
    const unsigned kl = (unsigned)lane * (unsigned)kpitch * 2u;
    const unsigned vl = ((unsigned)(lane >> 2) * (unsigned)vpitch + (unsigned)(lane & 3) * 8u) * 2u;
#pragma unroll
    for (int i = 0; i < (NP + 7) / 8; ++i) {
        const int pc = i * 8 + wid;
        if (pc < NP) {
            const char* ub; unsigned vo;
            if (pc < NKC) { ub = (const char*)ktile + pc * 16; vo = kl; }
            else { const int pv = pc - NKC, db = pv >> 2, kg = pv & 3; ub = (const char*)vtile + ((size_t)kg * 16 * vpitch + db * 32) * 2; vo = vl; }
            __builtin_amdgcn_global_load_lds((const unsigned*)(ub + vo), (LAS unsigned*)(buf + pc * 1024), 16, 0, 0);
        }
    }
}
__device__ __forceinline__ void wait_vm_bar(int n_pieces) {
    switch (n_pieces) {
        case 0: asm volatile("s_waitcnt vmcnt(0)" ::: "memory"); break;
        case 2: asm volatile("s_waitcnt vmcnt(2)" ::: "memory"); break;
        case 3: asm volatile("s_waitcnt vmcnt(3)" ::: "memory"); break;
        case 4: asm volatile("s_waitcnt vmcnt(4)" ::: "memory"); break;
        case 6: asm volatile("s_waitcnt vmcnt(6)" ::: "memory"); break;
        case 8: asm volatile("s_waitcnt vmcnt(8)" ::: "memory"); break;
        case 9: asm volatile("s_waitcnt vmcnt(9)" ::: "memory"); break;
        case 12: asm volatile("s_waitcnt vmcnt(12)" ::: "memory"); break;
        default: asm volatile("s_waitcnt vmcnt(0)" ::: "memory"); break;
    }
    asm volatile("s_waitcnt lgkmcnt(0)" ::: "memory"); __builtin_amdgcn_s_barrier(); asm volatile("" ::: "memory");
}
template <int NST, int PPW, class StageFn, class ComputeFn>
__device__ __forceinline__ void tile_stream(int tb, int te, StageFn stage, ComputeFn compute) {
#pragma unroll
    for (int s2 = 0; s2 < NST - 1; ++s2) if (tb + s2 <= te) stage(tb + s2, s2);
    int slot = 0;
    for (int t = tb; t <= te; ++t) {
        int ahead = te - t; ahead = ahead > NST - 2 ? NST - 2 : ahead;
        wait_vm_bar(ahead * PPW);
        int ns = slot + NST - 1; ns = ns >= NST ? ns - NST : ns;
        if (t + NST - 1 <= te) stage(t + NST - 1, ns);
        compute(t, slot);
        slot = (slot + 1 == NST) ? 0 : slot + 1;
    }
}

__device__ __forceinline__ float max3f(float a, float b, float c) { float r; asm("v_max3_f32 %0, %1, %2, %3" : "=v"(r) : "v"(a), "v"(b), "v"(c)); return r; }
__device__ __forceinline__ float max2f(float a, float b) { float r; asm("v_max_f32_e32 %0, %1, %2" : "=v"(r) : "v"(a), "v"(b)); return r; }
template <int OFF> __device__ __forceinline__ bf16x8 lds_r128(unsigned addr) { bf16x8 v; asm volatile("ds_read_b128 %0, %1 offset:%2" : "=v"(v) : "v"(addr), "i"(OFF)); return v; }
template <int OFF> __device__ __forceinline__ s16x4 lds_rtr(unsigned addr) { s16x4 v; asm volatile("ds_read_b64_tr_b16 %0, %1 offset:%2" : "=v"(v) : "v"(addr), "i"(OFF)); return v; }
#define LGKM_WAIT(n) do { asm volatile("s_waitcnt lgkmcnt(" #n ")" ::: "memory"); __builtin_amdgcn_sched_barrier(0); } while (0)
struct VFrag { s16x4 lo[4], hi[4]; };
__device__ __forceinline__ void vfrag_read(VFrag& f, unsigned va) {
    f.lo[0] = lds_rtr<0>(va); f.hi[0] = lds_rtr<512>(va); f.lo[1] = lds_rtr<1024>(va); f.hi[1] = lds_rtr<1536>(va);
    f.lo[2] = lds_rtr<2048>(va); f.hi[2] = lds_rtr<2560>(va); f.lo[3] = lds_rtr<3072>(va); f.hi[3] = lds_rtr<3584>(va);
}
#define VFR(f, k) (bf16x8){f.lo[k][0], f.lo[k][1], f.lo[k][2], f.lo[k][3], f.hi[k][0], f.hi[k][1], f.hi[k][2], f.hi[k][3]}
template <int DQ, int NDB, bool MASKED, class Post>
__device__ __forceinline__ void attn_qk_sm(const LAS unsigned char* kb, const bf16x8 (&qr)[DQ / 16], f32x16 p0, f32x16 p1,
                                           f32x16 (&o)[NDB], float& m, float& l, bool first, float& seen, int lane, Post post, bf16x8 (&pf)[4]) {
    constexpr float THR = 8.0f;
    const int r32 = lane & 31, hi = lane >> 5;
    const unsigned kaddr = (unsigned)(unsigned long)(kb + hi * 1024 + r32 * 16);
#pragma unroll
    for (int g = 0; g < DQ / 64; ++g) {
        const unsigned ka = kaddr + g * 8192;
        {   const bf16x8 k0 = lds_r128<0>(ka), k1 = lds_r128<512>(ka), k2 = lds_r128<2048>(ka), k3 = lds_r128<2560>(ka);
            LGKM_WAIT(0);
            p0 = MFMA32(k0, qr[4 * g], p0); p1 = MFMA32(k1, qr[4 * g], p1); p0 = MFMA32(k2, qr[4 * g + 1], p0); p1 = MFMA32(k3, qr[4 * g + 1], p1); }
        {   const bf16x8 k4 = lds_r128<4096>(ka), k5 = lds_r128<4608>(ka), k6 = lds_r128<6144>(ka), k7 = lds_r128<6656>(ka);
            LGKM_WAIT(0);
            p0 = MFMA32(k4, qr[4 * g + 2], p0); p1 = MFMA32(k5, qr[4 * g + 2], p1); p0 = MFMA32(k6, qr[4 * g + 3], p0); p1 = MFMA32(k7, qr[4 * g + 3], p1); }
    }
    post(p0, p1);
    asm volatile("s_nop 15\n\ts_nop 7" : "+v"(p0), "+v"(p1));
    float ma = max3f(p0[0], p0[1], p1[0]), mb = max3f(p0[2], p0[3], p1[1]); ma = max3f(ma, p1[2], p1[3]);
#pragma unroll
    for (int r = 4; r < 16; r += 4) { ma = max3f(ma, p0[r], p0[r + 1]); mb = max3f(mb, p0[r + 2], p0[r + 3]); ma = max3f(ma, p1[r], p1[r + 1]); mb = max3f(mb, p1[r + 2], p1[r + 3]); }
    float rm = max2f(ma, mb); rm = max2f(rm, __shfl_xor(rm, 32));
    float delta, alpha_on;
    if (MASKED) { const bool real = rm > -1e29f; delta = real ? ((seen == 0.f || rm > THR) ? rm : 0.f) : 0.f; alpha_on = seen; if (real) seen = 1.f; }
    else { delta = (first || rm > THR) ? rm : 0.f; alpha_on = first ? 0.f : 1.f; }
    if (__any(delta != 0.f)) {
        m += delta;
        const float alpha = (alpha_on != 0.f) ? __builtin_amdgcn_exp2f(-delta) : 1.0f;
#pragma unroll
        for (int r = 0; r < 16; ++r) { p0[r] -= delta; p1[r] -= delta; }
        l *= alpha;
#pragma unroll
        for (int db = 0; db < NDB; ++db) o[db] *= alpha;
    }
    float rs = 0.f;
#pragma unroll
    for (int r = 0; r < 16; ++r) { p0[r] = __builtin_amdgcn_exp2f(p0[r]); p1[r] = __builtin_amdgcn_exp2f(p1[r]); rs += p0[r] + p1[r]; }
    l += rs;
    pf[0] = pack8(p0[0], p0[1], p0[2], p0[3], p0[4], p0[5], p0[6], p0[7]); pf[1] = pack8(p0[8], p0[9], p0[10], p0[11], p0[12], p0[13], p0[14], p0[15]);
    pf[2] = pack8(p1[0], p1[1], p1[2], p1[3], p1[4], p1[5], p1[6], p1[7]); pf[3] = pack8(p1[8], p1[9], p1[10], p1[11], p1[12], p1[13], p1[14], p1[15]);
}
template <int NDB, bool PIPE>
__device__ __forceinline__ void attn_pv(const LAS unsigned char* vb, const bf16x8 (&pf)[4], f32x16 (&o)[NDB], int lane) {
    const int hi = lane >> 5;
    const unsigned vaddr = (unsigned)(unsigned long)(vb + (4 * hi + ((lane & 15) >> 2)) * 64 + ((lane >> 4) & 1) * 32 + (lane & 3) * 8);
    VFrag fa, fb;
    if (PIPE) {
        vfrag_read(fa, vaddr);
#pragma unroll
        for (int db = 0; db < NDB; ++db) {
            VFrag& cur = (db & 1) ? fb : fa; VFrag& nxt = (db & 1) ? fa : fb;
            if (db + 1 < NDB) { vfrag_read(nxt, vaddr + (db + 1) * 4096); LGKM_WAIT(8); } else { LGKM_WAIT(0); }
            o[db] = MFMA32(VFR(cur, 0), pf[0], o[db]); o[db] = MFMA32(VFR(cur, 1), pf[1], o[db]); o[db] = MFMA32(VFR(cur, 2), pf[2], o[db]); o[db] = MFMA32(VFR(cur, 3), pf[3], o[db]);
        }
    } else {
#pragma unroll
        for (int db = 0; db < NDB; ++db) {
            vfrag_read(fa, vaddr + db * 4096); LGKM_WAIT(0);
            o[db] = MFMA32(VFR(fa, 0), pf[0], o[db]); o[db] = MFMA32(VFR(fa, 1), pf[1], o[db]); o[db] = MFMA32(VFR(fa, 2), pf[2], o[db]); o[db] = MFMA32(VFR(fa, 3), pf[3], o[db]);
        }
    }
}
template <int DQ, int NDB, bool MASKED, class Post>
__device__ __forceinline__ void attn_step(const LAS unsigned char* kb, const LAS unsigned char* vb, const bf16x8 (&qr)[DQ / 16], f32x16 p0, f32x16 p1,
                                          f32x16 (&o)[NDB], float& m, float& l, bool first, float& seen, int lane, Post post) {
    bf16x8 pf[4];
    attn_qk_sm<DQ, NDB, MASKED>(kb, qr, p0, p1, o, m, l, first, seen, lane, post, pf);
    attn_pv<NDB, (DQ == 64)>(vb, pf, o, lane);
}
template <int NST, int PPW, class StageFn, class QkFn, class PvFn>
__device__ __forceinline__ void tile_stream_stag(int tb, int te, bool trailing, StageFn stage, QkFn qk, PvFn pv) {
#pragma unroll
    for (int s2 = 0; s2 < NST - 2; ++s2) if (tb + s2 <= te) stage(tb + s2, s2);
    int slot = 0, pslot = 0;
    for (int t = tb; t <= te; ++t) {
        int ahead = te - t; ahead = ahead > NST - 3 ? NST - 3 : ahead;
        wait_vm_bar(ahead * PPW);
        int ns = slot + NST - 2; ns = ns >= NST ? ns - NST : ns;
        if (t + NST - 2 <= te) stage(t + NST - 2, ns);
        if (trailing) { if (t > tb) pv(t - 1, pslot); qk(t, slot); }
        else { qk(t, slot); pv(t, slot); }
        pslot = slot; slot = (slot + 1 == NST) ? 0 : slot + 1;
    }
    if (trailing && te >= tb) pv(te, pslot);
}
__device__ __forceinline__ void store_o16(bf16_t* dst, const f32x16& o, float sc, int hi) {
#pragma unroll
    for (int g = 0; g < 4; ++g) { u32x2 w; w.x = pk2(o[4 * g] * sc, o[4 * g + 1] * sc); w.y = pk2(o[4 * g + 2] * sc, o[4 * g + 3] * sc); *(u32x2*)(dst + 8 * g + 4 * hi) = w; }
}


__device__ __forceinline__ int pop_unit(CParams& p, int ctr, LAS unsigned char* lds, int tid) {
    wg_sync();
    if (tid == 0) *(LAS int*)(lds + LDS_MISC + 2048) = atomicAdd((int*)(WSX + CT_QCTR) + ctr * 16, 1);
    wg_sync();
    return *(const LAS int*)(lds + LDS_MISC + 2048);
}
__device__ __forceinline__ void ph_norms(CParams& p, int layer, LAS unsigned char* lds, int WIDS) {
    const int tid = TIDX, lane = tid & 63, w = tid >> 6;
    const bf16_t* proj = (const bf16_t*)(WSX + WS_BIG);
    float mx[4] = {0.f, 0.f, 0.f, 0.f};
    for (int tok = BIDX * 8 + w; tok < T; tok += GDIM * 8) {
        const bf16_t* row = proj + (size_t)tok * NINP;
#pragma unroll
        for (int k = 0; k < 2; ++k) {
            const int off = (k == 0) ? OFF_QA : OFF_KA; const int width = 512;
            float ss = 0.f;
            if (lane * 8 < width) { const u32x4 v = *(const u32x4*)(row + off + lane * 8);
                const float e0 = __uint_as_float(v.x << 16), e1 = __uint_as_float(v.x & 0xffff0000u), e2 = __uint_as_float(v.y << 16), e3 = __uint_as_float(v.y & 0xffff0000u);
                const float e4 = __uint_as_float(v.z << 16), e5 = __uint_as_float(v.z & 0xffff0000u), e6 = __uint_as_float(v.w << 16), e7 = __uint_as_float(v.w & 0xffff0000u);
                ss = (e0 * e0 + e1 * e1) + (e2 * e2 + e3 * e3) + (e4 * e4 + e5 * e5) + (e6 * e6 + e7 * e7); }
            ss += __shfl_xor(ss, 1); ss += __shfl_xor(ss, 2); ss += __shfl_xor(ss, 4);
            mx[k] = fmaxf(mx[k], ss);
        }
    }
    LAS float* red = (LAS float*)(lds + LDS_MISC + 4096);
    __syncthreads();
#pragma unroll
    for (int k = 0; k < 4; ++k) { float v = mx[k];
#pragma unroll
        for (int o = 32; o > 0; o >>= 1) v = fmaxf(v, __shfl_xor(v, o));
        if (lane == 0) red[w * 4 + k] = v; }
    __syncthreads();
    if (tid < 4) { float v = red[tid]; for (int ww = 1; ww < 8; ++ww) v = fmaxf(v, red[ww * 4 + tid]); ((float*)(WSX + CT_NORM))[(layer * 512 + BIDX) * 4 + tid] = v; }
    __syncthreads();
}
__device__ __forceinline__ float norm_max(CParams& p, int layer, int k, int lane) {
    const float* arr = (const float*)(WSX + CT_NORM) + (size_t)layer * 512 * 4; float v = 0.f; const int G = GDIM;
    for (int bb = lane; bb < G; bb += 64) v = fmaxf(v, arr[bb * 4 + k]);
#pragma unroll
    for (int o = 32; o > 0; o >>= 1) v = fmaxf(v, __shfl_xor(v, o));
    return v;
}

__device__ __forceinline__ void cross_unit(CParams& p, LAS unsigned char* lds, int WIDS, int b, int h, int qb) {
    const int tid = TIDX, lane = tid & 63, wid = __builtin_amdgcn_readfirstlane(tid >> 6), r32 = lane & 31, hi = lane >> 5;
    const int qg = wid & 3, dvh = wid >> 2;
    const bf16_t* Qx = (const bf16_t*)(WSX + WS_BIG); const bf16_t* KV = (const bf16_t*)(WSX + WS_KV); bf16_t* O = (bf16_t*)(WSX + WS_B1);
    constexpr int TILE = 65536; const float c2 = 0.0625f * LOG2E;
    {
        const int tok = b * S + qb * 128 + qg * 32 + r32;
        bf16x8 qr[16];
#pragma unroll
        for (int d0 = 0; d0 < 16; ++d0) qr[d0] = scale8(*(const u32x4*)(Qx + (size_t)tok * D + h * 256 + d0 * 16 + hi * 8), c2);
        f32x16 o[4];
#pragma unroll
        for (int db = 0; db < 4; ++db)
#pragma unroll
            for (int r = 0; r < 16; ++r) o[db][r] = 0.f;
        float m = 0.f, l = 0.f, seen = 0.f;
        const bf16_t* kt0 = KV + (size_t)(b * NMEM) * 2048 + h * 256; const bf16_t* vt0 = kt0 + 1024;
        wg_sync();
        stage_tile<32, 8>(lds, kt0, 2048, vt0, 2048, wid, lane);
        for (int t = 0; t < 4; ++t) {
            wg_sync();
            if (t + 1 < 4) stage_tile<32, 8>(lds + ((t + 1) & 1) * TILE, kt0 + (size_t)(t + 1) * 64 * 2048, 2048, vt0 + (size_t)(t + 1) * 64 * 2048, 2048, wid, lane);
            const LAS unsigned char* buf = lds + (t & 1) * TILE;
            f32x16 z;
#pragma unroll
            for (int r = 0; r < 16; ++r) z[r] = -m;
            attn_step<256, 4, false>(buf, buf + 32768 + dvh * 16384, qr, z, z, o, m, l, t == 0, seen, lane, [](f32x16&, f32x16&) {});
        }
        l += __shfl_xor(l, 32); const float inv = 1.0f / l;
        { const int tid2 = TIDX, lane2 = tid2 & 63, wid2 = tid2 >> 6;
          const int tok2 = b * S + qb * 128 + (wid2 & 3) * 32 + (lane2 & 31);
          bf16_t* orow = O + (size_t)tok2 * D + h * 256 + (wid2 >> 2) * 128;
#pragma unroll
          for (int db = 0; db < 4; ++db) store_o16(orow + db * 32, o[db], inv, lane2 >> 5); }
    }
}

__device__ __forceinline__ void ph_band(CParams& p, int layer, LAS unsigned char* lds, int WIDS) {
    const int tid = TIDX, lane = tid & 63, wid = __builtin_amdgcn_readfirstlane(tid >> 6), r32 = lane & 31, hi = lane >> 5;
    const bf16_t* proj = (const bf16_t*)(WSX + WS_BIG); bf16_t* Y = (bf16_t*)(WSX + WS_B1);
    constexpr int TILE = 16384; const float c2 = 0.125f * LOG2E;
    LAS float* tbl = (LAS float*)(lds + 4 * TILE);
    for (int u = BIDX; u < NB * 4 * 16; u += GDIM) {
        const int qb = u & 15, h = (u >> 4) & 3, b = u >> 6;
        const int cw = 4 * qb + (wid >> 1), tq = 64 * cw + 32 * (wid & 1) + r32, tok = b * S + tq;
        bf16x8 qr[4];
#pragma unroll
        for (int d0 = 0; d0 < 4; ++d0) qr[d0] = scale8(*(const u32x4*)(proj + (size_t)tok * NINP + OFF_QB + h * 64 + d0 * 16 + hi * 8), c2);
        f32x16 o[2];
#pragma unroll
        for (int db = 0; db < 2; ++db)
#pragma unroll
            for (int r = 0; r < 16; ++r) o[db][r] = 0.f;
        float m = 0.f, l = 0.f, seen = 0.f;
        const int t0 = 4 * qb - 8 < 0 ? 0 : 4 * qb - 8, t1 = 4 * qb + 3;
        const bf16_t* kb0 = proj + (size_t)(b * S) * NINP + OFF_KB + h * 64; const bf16_t* vb0 = proj + (size_t)(b * S) * NINP + OFF_VB + h * 64;
        wg_sync();
        if (tid < 257) tbl[tid] = asg(p.relb)[(layer * 4 + h) * 257 + tid] * LOG2E;
        tile_stream<4, 2>(t0, t1,
            [&](int t, int slot) { stage_tile<8, 2>(lds + slot * TILE, kb0 + (size_t)t * 64 * NINP, NINP, vb0 + (size_t)t * 64 * NINP, NINP, wid, lane); },
            [&](int t, int slot) {
                if (t >= cw - 8 && t <= cw) {
                    const LAS unsigned char* buf = lds + slot * TILE;
                    f32x16 p0, p1;
                    if (cw - t >= 3) { const float cb = tbl[256] - m;
#pragma unroll
                        for (int r = 0; r < 16; ++r) { p0[r] = cb; p1[r] = cb; } }
                    else { const int rel0 = tq - (64 * t + 4 * hi);
#pragma unroll
                        for (int r = 0; r < 16; ++r) { const int c = (r & 3) + 8 * (r >> 2); int ra = rel0 - c, rb = rel0 - c - 32;
                            ra = ra < -128 ? -128 : (ra > 128 ? 128 : ra); rb = rb < -128 ? -128 : (rb > 128 ? 128 : rb);
                            p0[r] = tbl[ra + 128] - m; p1[r] = tbl[rb + 128] - m; } }
                    attn_step<64, 2, false>(buf, buf + 8192, qr, p0, p1, o, m, l, t == (cw - 8 < 0 ? 0 : cw - 8), seen, lane, [](f32x16&, f32x16&) {});
                } });
        l += __shfl_xor(l, 32); const float inv = 1.0f / l;
        bf16_t* orow = Y + (size_t)tok * D + 512 + h * 64;
#pragma unroll
        for (int db = 0; db < 2; ++db) store_o16(orow + db * 32, o[db], inv, hi);
    }
    wg_sync();
}

__device__ __forceinline__ void ph_diff(CParams& p, int layer, LAS unsigned char* lds, int WIDS) {
    const int tid0 = TIDX;
    const bf16_t* proj = (const bf16_t*)(WSX + WS_BIG); bf16_t* Y = (bf16_t*)(WSX + WS_B1);
    const float* lamp = (const float*)(WSX + CT_LAM); const float lam = lamp[layer * 2], lam_init = lamp[layer * 2 + 1];
    const float* gain = asg(p.dgain) + layer * 128;
    constexpr int TILE = 32768; const float c2 = 0.125f * LOG2E;
    const int G = GDIM, bid = BIDX; const int vcu = (G % 8 == 0) ? (bid % 8) * (G / 8) + bid / 8 : bid;
    LAS float* gl = (LAS float*)(lds + LDS_MISC + 1024);
    if (tid0 < 128) gl[tid0] = gain[tid0] * (1.0f - lam_init);
    const int nq = (G % 8 == 0) ? 8 : 1, qid = bid % nq, ctr = (layer * 3 + 0) * 8 + qid;
    const float Bq = c2 * sqrtf(norm_max(p, layer, 0, tid0 & 63) * norm_max(p, layer, 1, tid0 & 63)) * 1.01f;
    for (;;) {
        const int tid = TIDX, lane = tid & 63, wid = __builtin_amdgcn_readfirstlane(tid >> 6), r32 = lane & 31, hi = lane >> 5;
        const int qg = wid & 3, map = wid >> 2;
        const int idx = pop_unit(p, ctr, lds, tid);
        if (idx >= (NB * 4 * 32) / nq) break;
        const int u = (qid + nq * (idx >> 7)) * 128 + (idx & 3) * 32 + (31 - ((idx & 127) >> 2));
        const int qb = u & 31, h = (u >> 5) & 3, b = u >> 7;
        const int tq = 128 * qb + 32 * qg + r32, tok = b * S + tq, cq = 2 * qb + (qg >> 1);
        const float slope2 = exp2f(-(float)(2 * h + 1)) * LOG2E;
        bf16x8 qr[4];
#pragma unroll
        for (int d0 = 0; d0 < 4; ++d0) qr[d0] = scale8(*(const u32x4*)(proj + (size_t)tok * NINP + OFF_QA + h * 128 + map * 64 + d0 * 16 + hi * 8), c2);
        f32x16 o[4];
#pragma unroll
        for (int db = 0; db < 4; ++db)
#pragma unroll
            for (int r = 0; r < 16; ++r) o[db][r] = 0.f;
        float m = 0.f, l = 0.f, seen = 0.f;
        const int t1 = 2 * qb + 1;
        int ts = (int)ceilf(((float)(128 * qb - 63) - (160.0f + 2.0f * Bq) / slope2) * (1.0f / 64.0f)); ts = ts < 0 ? 0 : ts; ts = __builtin_amdgcn_readfirstlane(ts);
        const bf16_t* kb0 = proj + (size_t)(b * S) * NINP + OFF_KA + h * 128; const bf16_t* vb0 = proj + (size_t)(b * S) * NINP + OFF_VA + h * 128;
        wg_sync();
        tile_stream<4, 4>(ts, t1,
            [&](int t, int slot) { stage_tile<16, 4>(lds + slot * TILE, kb0 + (size_t)t * 64 * NINP, NINP, vb0 + (size_t)t * 64 * NINP, NINP, wid, lane); },
            [&](int t, int slot) {
                if (t <= cq) {
                    const LAS unsigned char* buf = lds + slot * TILE;
                    f32x16 p0, p1; const float dq = (float)(64 * t + 4 * hi - tq);
                    if (t == cq) {
#pragma unroll
                        for (int r = 0; r < 16; ++r) { const float c = (float)((r & 3) + 8 * (r >> 2)); p0[r] = fmaf(-slope2, fabsf(dq + c), -m); p1[r] = fmaf(-slope2, fabsf(dq + c + 32.0f), -m); }
                    } else { const float sb = slope2 * dq - m;
#pragma unroll
                        for (int r = 0; r < 16; ++r) { const float c = (float)((r & 3) + 8 * (r >> 2)); p0[r] = fmaf(slope2, c, sb); p1[r] = fmaf(slope2, c + 32.0f, sb); }
                    }
                    attn_step<64, 4, false>(buf + map * 8192, buf + 16384, qr, p0, p1, o, m, l, t == ts, seen, lane, [](f32x16&, f32x16&) {});
                } });
        l += __shfl_xor(l, 32); const float inv = 1.0f / l;
        wg_sync();
        LAS float* xch = (LAS float*)lds + qg * 4096 + r32;
        if (map == 1) {
#pragma unroll
            for (int db = 0; db < 4; ++db)
#pragma unroll
                for (int r = 0; r < 16; ++r) xch[(db * 32 + (r & 3) + 8 * (r >> 2) + 4 * hi) * 32] = o[db][r] * inv;
        }
        wg_sync();
        if (map == 0) {
            float ss = 0.f;
#pragma unroll
            for (int db = 0; db < 4; ++db)
#pragma unroll
                for (int r = 0; r < 16; ++r) { const float y = o[db][r] * inv - lam * xch[(db * 32 + (r & 3) + 8 * (r >> 2) + 4 * hi) * 32]; o[db][r] = y; ss += y * y; }
            ss += __shfl_xor(ss, 32);
            const float rn = rsqrtf(ss * (1.0f / 128.0f) + RMS_EPS);
            bf16_t* orow = Y + (size_t)tok * D + h * 128;
#pragma unroll
            for (int db = 0; db < 4; ++db)
#pragma unroll
                for (int g = 0; g < 4; ++g) { const int d = db * 32 + 8 * g + 4 * hi; const f32x4 gn = *(const LAS f32x4*)(gl + d);
                    u32x2 w; w.x = pk2(o[db][4 * g] * rn * gn[0], o[db][4 * g + 1] * rn * gn[1]); w.y = pk2(o[db][4 * g + 2] * rn * gn[2], o[db][4 * g + 3] * rn * gn[3]);
                    *(u32x2*)(orow + d) = w; }
        }
    }
    wg_sync();
}

__device__ __forceinline__ size_t isc_tri(int c) { return (size_t)4096 * (size_t)(c * (c + 1) / 2); }
#define ISC_PTR(b_) ((b_) < ISC_IN_WBIG ? (float*)(WSX + WS_WBIG) + (size_t)(b_) * ISC_BATCH : (float*)asg(p.out) + (size_t)((b_) - ISC_IN_WBIG) * ISC_BATCH)
#define MASK_PTR ((unsigned long long*)((unsigned char*)asg(p.out) + OUT_MASK))
__device__ __forceinline__ void wave_lds_sync() { asm volatile("s_waitcnt lgkmcnt(0)" ::: "memory"); }

__device__ __forceinline__ unsigned fkey32(float f) { const unsigned u = __float_as_uint(f); return (u & 0x80000000u) ? ~u : (u | 0x80000000u); }
__device__ __forceinline__ void d2_chunk_pair(CParams& p, int b, int cp, LAS unsigned char* lds, int WIDS) {
    const int tid = TIDX; int lane = tid & 63; const int wid = __builtin_amdgcn_readfirstlane(tid >> 6);
    unsigned long long* mask = MASK_PTR;
    LAS unsigned* hist = (LAS unsigned*)(lds + wid * 9216);
    LAS unsigned* list = hist + 1024;
    LAS unsigned* rowb = list + 1024;
    LAS unsigned* lcnt = rowb + 128;
    const float NINF = -INFINITY;
    const int lane0 = lane;
    f32x4 v[16];
#define D2_ROW_T(i2) (64 * (((i2) & 1) ? 63 - cp : cp) + wid + 8 * ((i2) >> 1))
#define D2_LOAD_ROW(tx) do { const int bl_ = b, t_ = (tx), c_ = t_ >> 6, n_ = 64 * (c_ + 1); \
        const float* row_ = ISC_PTR(bl_) + isc_tri(c_) + (size_t)(t_ & 63) * (size_t)n_; \
        _Pragma("unroll") for (int i = 0; i < 16; ++i) { if (256 * i + 4 * lane < n_) v[i] = *(const f32x4*)(row_ + 256 * i + 4 * lane); else v[i] = (f32x4){NINF, NINF, NINF, NINF}; } } while (0)
    D2_LOAD_ROW(D2_ROW_T(0));
    for (int i2 = 0; i2 < 16; ++i2) {
        int lane = lane0; asm volatile("" : "+v"(lane));
        const int t = D2_ROW_T(i2), c = t >> 6, n = 64 * (c + 1);
        rowb[lane] = 0u; rowb[lane + 64] = 0u; if (lane == 0) lcnt[0] = 0u;
        unsigned long long selbits = 0ull; bool rank_list = false; unsigned need_r = 0, cstar_r = 0;
        if (n <= 256) { selbits = (4 * lane < n) ? 0xFull : 0ull; }
        else {
            float lo = INFINITY, hi = NINF;
#pragma unroll
            for (int i = 0; i < 16; ++i) if (256 * i + 4 * lane < n) {
#pragma unroll
                for (int q = 0; q < 4; ++q) { lo = fminf(lo, v[i][q]); hi = fmaxf(hi, v[i][q]); } }
#pragma unroll
            for (int o = 32; o > 0; o >>= 1) { lo = fminf(lo, __shfl_xor(lo, o)); hi = fmaxf(hi, __shfl_xor(hi, o)); }
            const float scale = (hi > lo) ? 1024.0f / (hi - lo) : 0.f;
#pragma unroll
            for (int q = 0; q < 16; ++q) hist[q * 64 + lane] = 0u;
            wave_lds_sync();
#define BUCKET(x) min(1023, (int)(((x) - lo) * scale))
#pragma unroll
            for (int i = 0; i < 16; ++i) if (256 * i + 4 * lane < n) {
#pragma unroll
                for (int q = 0; q < 4; ++q) (void)__hip_atomic_fetch_add(hist + BUCKET(v[i][q]), 1u, __ATOMIC_RELAXED, __HIP_MEMORY_SCOPE_WORKGROUP); }
            wave_lds_sync();
            unsigned hb[16]; unsigned ssum = 0;
#pragma unroll
            for (int q = 0; q < 4; ++q) { const u32x4 x = *(const LAS u32x4*)(hist + 16 * lane + 4 * q); hb[4 * q] = x.x; hb[4 * q + 1] = x.y; hb[4 * q + 2] = x.z; hb[4 * q + 3] = x.w; ssum += x.x + x.y + x.z + x.w; }
            unsigned incl = ssum;
#pragma unroll
            for (int o = 1; o < 64; o <<= 1) { const unsigned tt = __shfl_down(incl, o); if (lane + o < 64) incl += tt; }
            const unsigned long long bal = __ballot(incl >= 256u);
            const int L = 63 - __clzll(bal);
            unsigned cum = incl - ssum, cab = 0, cst = 0; int bks = 0; bool found = false;
#pragma unroll
            for (int bk = 15; bk >= 0; --bk) { if (!found && cum + hb[bk] >= 256u) { found = true; bks = bk; cab = cum; cst = hb[bk]; } if (!found) cum += hb[bk]; }
            const int bstar = __shfl(16 * lane + bks, L); const unsigned cnt_above = __shfl(cab, L), cstar = __shfl(cst, L);
            const unsigned need = 256u - cnt_above;
            const bool listmode = (need != cstar);
#pragma unroll
            for (int i = 0; i < 16; ++i) if (256 * i + 4 * lane < n) {
#pragma unroll
                for (int q = 0; q < 4; ++q) { const int bk = BUCKET(v[i][q]);
                    if (bk > bstar || (bk == bstar && !listmode)) selbits |= 1ull << (4 * i + q);
                    else if (bk == bstar) { const unsigned slot = __hip_atomic_fetch_add(lcnt, 1u, __ATOMIC_RELAXED, __HIP_MEMORY_SCOPE_WORKGROUP);
                        if (slot < 512u) { list[2 * slot] = fkey32(v[i][q]); list[2 * slot + 1] = (unsigned)(256 * i + 4 * lane + q); } } } }
            if (listmode) {
                if (cstar <= 512u) { rank_list = true; need_r = need; cstar_r = cstar; }
                else {
                    unsigned long long Tk = 0ull;
                    for (int bit = 43; bit >= 0; --bit) { const unsigned long long trial = Tk | (1ull << bit); unsigned cc = 0;
#pragma unroll
                        for (int i = 0; i < 16; ++i) if (256 * i + 4 * lane < n) {
#pragma unroll
                            for (int q = 0; q < 4; ++q) { const unsigned long long ck = ((unsigned long long)fkey32(v[i][q]) << 12) | (unsigned long long)(4095 - (256 * i + 4 * lane + q));
                                cc += (BUCKET(v[i][q]) == bstar && ck >= trial) ? 1u : 0u; } }
#pragma unroll
                        for (int o = 32; o > 0; o >>= 1) cc += __shfl_xor(cc, o);
                        if (cc >= need) Tk = trial; }
#pragma unroll
                    for (int i = 0; i < 16; ++i) if (256 * i + 4 * lane < n) {
#pragma unroll
                        for (int q = 0; q < 4; ++q) { const unsigned long long ck = ((unsigned long long)fkey32(v[i][q]) << 12) | (unsigned long long)(4095 - (256 * i + 4 * lane + q));
                            if (BUCKET(v[i][q]) == bstar && ck >= Tk) selbits |= 1ull << (4 * i + q); } }
                }
            }
#undef BUCKET
        }
        if (i2 + 1 < 16) D2_LOAD_ROW(D2_ROW_T(i2 + 1));
        if (rank_list) {
            wave_lds_sync();
            for (unsigned e = lane; e < cstar_r; e += 64) { const unsigned mk = list[2 * e], mi = list[2 * e + 1]; unsigned rank = 0;
                for (unsigned j2 = 0; j2 < cstar_r; ++j2) { const unsigned k2 = list[2 * j2], i2 = list[2 * j2 + 1]; rank += (k2 > mk || (k2 == mk && i2 < mi)) ? 1u : 0u; }
                if (rank < need_r) (void)__hip_atomic_fetch_or(rowb + (mi >> 5), 1u << (mi & 31), __ATOMIC_RELAXED, __HIP_MEMORY_SCOPE_WORKGROUP); }
        }
#pragma unroll
        for (int i = 0; i < 16; ++i) { const unsigned nib = (unsigned)(selbits >> (4 * i)) & 0xFu;
            if (nib) (void)__hip_atomic_fetch_or(rowb + 8 * i + (lane >> 3), nib << (4 * (lane & 7)), __ATOMIC_RELAXED, __HIP_MEMORY_SCOPE_WORKGROUP); }
        wave_lds_sync();
        if (lane <= c) mask[((size_t)b * 64 + lane) * S + t] = (unsigned long long)rowb[2 * lane] | ((unsigned long long)rowb[2 * lane + 1] << 32);
        wave_lds_sync();
    }
#undef D2_LOAD_ROW
#undef D2_ROW_T
    wg_sync();
}

__device__ __forceinline__ void ph_d1(CParams& p, int round, LAS unsigned char* lds, int WIDS) {
    const int tid = TIDX, lane = tid & 63, wid = __builtin_amdgcn_readfirstlane(tid >> 6), r32 = lane & 31, hi = lane >> 5;
    const int qh = wid & 1, j = wid >> 1;
    const bf16_t* proj = (const bf16_t*)(WSX + WS_BIG);
    const int G = GDIM, bid = BIDX; const int vcu = (G % 8 == 0) ? (bid % 8) * (G / 8) + bid / 8 : bid;
    for (int s = vcu; s < 256; s += G) {
        const int b = s >> 5, cp = s & 31;
        for (int k2 = 0; k2 < 2; ++k2) {
            const int c = k2 == 0 ? cp : 63 - cp;
            wg_sync();
#pragma unroll
            for (int i = 0; i < 8; ++i) { const int pc = i * 8 + wid;
                __builtin_amdgcn_global_load_lds((const unsigned*)(proj + (size_t)(b * S + 64 * c + lane) * NINP + OFF_QI + pc * 8), (LAS unsigned*)(lds + pc * 1024), 16, 0, 0); }
            const int tokq = b * S + 64 * c + qh * 32 + r32;
            float w[8];
            { const u32x4 wv = *(const u32x4*)(proj + (size_t)tokq * NINP + OFF_WI); const float sc = 0.125f * 0.35355339059f;
              w[0] = __uint_as_float(wv.x << 16) * sc; w[1] = __uint_as_float(wv.x & 0xffff0000u) * sc; w[2] = __uint_as_float(wv.y << 16) * sc; w[3] = __uint_as_float(wv.y & 0xffff0000u) * sc;
              w[4] = __uint_as_float(wv.z << 16) * sc; w[5] = __uint_as_float(wv.z & 0xffff0000u) * sc; w[6] = __uint_as_float(wv.w << 16) * sc; w[7] = __uint_as_float(wv.w & 0xffff0000u) * sc; }
            LAS float* wq = (LAS float*)(lds + LDS_MISC + 4096) + qh * 32 + r32;
            if (hi == 0) {
#pragma unroll
                for (int h = 0; h < 8; ++h) wq[h * 64] = w[h]; }
            wg_sync();
            float* orow = ISC_PTR(b) + isc_tri(c) + (size_t)(qh * 32 + r32) * (size_t)(64 * (c + 1));
            const LAS unsigned char* qp = lds + hi * 1024 + (qh * 32 + r32) * 16;
            LAS unsigned char* kring = lds + 65536;
            const int nit = (c + 4) >> 2;
#define D1_STAGE(it, slot) do { const int t_ = j + 4 * (it); if (t_ <= c) { _Pragma("unroll") for (int pc_ = 0; pc_ < 4; ++pc_) { const int ch_ = qh * 4 + pc_; \
            glds16(proj + (size_t)(b * S + 64 * t_ + lane) * NINP + OFF_KI + ch_ * 8, (unsigned)(unsigned long)(kring + (slot) * 32768 + j * 8192 + ch_ * 1024)); } } } while (0)
#define D1_STORE(ts) do { const int ts_ = (ts); _Pragma("unroll") for (int g = 0; g < 4; ++g) { \
                const f32x4 s0 = {a0[4 * g] + 0.f, a0[4 * g + 1] + 0.f, a0[4 * g + 2] + 0.f, a0[4 * g + 3] + 0.f}; \
                const f32x4 s1 = {a1[4 * g] + 0.f, a1[4 * g + 1] + 0.f, a1[4 * g + 2] + 0.f, a1[4 * g + 3] + 0.f}; \
                *(f32x4*)(orow + 64 * ts_ + 8 * g + 4 * hi) = s0; *(f32x4*)(orow + 64 * ts_ + 32 + 8 * g + 4 * hi) = s1; } } while (0)
            f32x16 a0, a1;
#pragma unroll
            for (int r = 0; r < 16; ++r) { a0[r] = 0.f; a1[r] = 0.f; }
            D1_STAGE(0, 0);
            for (int it = 0; it < nit; ++it) {
                const int t = j + 4 * it;
                asm volatile("s_waitcnt vmcnt(0)" ::: "memory"); __builtin_amdgcn_s_barrier(); asm volatile("" ::: "memory");
                if (it + 1 < nit) D1_STAGE(it + 1, (it + 1) & 1);
                if (it > 0) D1_STORE(t - 4);
                if (t > c) continue;
                const LAS unsigned char* kt = kring + (it & 1) * 32768 + j * 8192 + hi * 1024 + r32 * 16;
                bf16x8 ka[2][4];
#pragma unroll
                for (int kh = 0; kh < 2; ++kh)
#pragma unroll
                    for (int d0 = 0; d0 < 4; ++d0) ka[kh][d0] = *(const LAS bf16x8*)(kt + d0 * 2048 + kh * 512);
#pragma unroll
                for (int r = 0; r < 16; ++r) { a0[r] = 0.f; a1[r] = 0.f; }
#define D1_QK(P0, P1, hh) do { _Pragma("unroll") for (int r = 0; r < 16; ++r) { P0[r] = 0.f; P1[r] = 0.f; } \
        _Pragma("unroll") for (int d0 = 0; d0 < 4; ++d0) { const bf16x8 bq = *(const LAS bf16x8*)(qp + ((hh) * 8 + 2 * d0) * 1024); P0 = MFMA32(ka[0][d0], bq, P0); P1 = MFMA32(ka[1][d0], bq, P1); } } while (0)
#define D1_ACC(P0, P1, hh) do { const float wh_ = wq[(hh) * 64]; \
        _Pragma("unroll") for (int r = 0; r < 16; ++r) { a0[r] = fmaf(wh_, __int_as_float(max(__float_as_int(P0[r]), 0)), a0[r]); a1[r] = fmaf(wh_, __int_as_float(max(__float_as_int(P1[r]), 0)), a1[r]); } \
        asm volatile("" : "+v"(a0), "+v"(a1)); } while (0)
                f32x16 pa0, pa1, pb0, pb1;
                D1_QK(pa0, pa1, 0);
#pragma unroll 1
                for (int h = 0; h < 8; h += 2) {
                    D1_QK(pb0, pb1, h + 1);
                    __builtin_amdgcn_sched_barrier(0);
                    D1_ACC(pa0, pa1, h);
                    if (h + 2 < 8) D1_QK(pa0, pa1, h + 2);
                    __builtin_amdgcn_sched_barrier(0);
                    D1_ACC(pb0, pb1, h + 1);
                }
#undef D1_QK
#undef D1_ACC
            }
            if (j + 4 * (nit - 1) <= c) D1_STORE(j + 4 * (nit - 1));
#undef D1_STORE
#undef D1_STAGE
        }
        wg_sync();
        d2_chunk_pair(p, b, cp, lds, WIDS);
    }
    wg_sync();
}

__device__ __forceinline__ void ph_d3(CParams& p, int layer, LAS unsigned char* lds, int WIDS) {
    const int tid = TIDX, lane = tid & 63, wid = __builtin_amdgcn_readfirstlane(tid >> 6), r32 = lane & 31, hi = lane >> 5;
    const int qg = wid;
    const bf16_t* proj = (const bf16_t*)(WSX + WS_BIG); bf16_t* Y = (bf16_t*)(WSX + WS_B1);
    const unsigned long long* mask = MASK_PTR;
    constexpr int TILE = 18432; const float c2 = 0.125f * LOG2E;
    const int G = GDIM, bid = BIDX; const int vcu = (G % 8 == 0) ? (bid % 8) * (G / 8) + bid / 8 : bid;
    const int nq = (G % 8 == 0) ? 8 : 1, qid = bid % nq, ctr = (layer * 3 + 1) * 8 + qid;
    for (;;) {
        const int idx = pop_unit(p, ctr, lds, tid);
        if (idx >= (NB * 4 * 16) / nq) break;
        const int u = (qid + nq * (idx >> 6)) * 64 + (idx & 3) * 16 + (15 - ((idx & 63) >> 2));
        const int qb = u & 15, h = (u >> 4) & 3, b = u >> 6;
        const int tq = 256 * qb + 32 * qg + r32, tok = b * S + tq, cq = 4 * qb + (qg >> 1);
        const float slope2 = exp2f(-(float)(2 * h + 2)) * LOG2E;
        bf16x8 qr[4];
#pragma unroll
        for (int d0 = 0; d0 < 4; ++d0) qr[d0] = scale8(*(const u32x4*)(proj + (size_t)tok * NINP + OFF_QC + h * 64 + d0 * 16 + hi * 8), c2);
        f32x16 o[2];
#pragma unroll
        for (int db = 0; db < 2; ++db)
#pragma unroll
            for (int r = 0; r < 16; ++r) o[db][r] = 0.f;
        float m = 0.f, l = 0.f, seen = 0.f;
        const int t1 = 4 * qb + 3;
        const bf16_t* kb0 = proj + (size_t)(b * S) * NINP + OFF_KC + h * 64; const bf16_t* vb0 = proj + (size_t)(b * S) * NINP + OFF_VC + h * 64;
        const unsigned* mbase = (const unsigned*)(mask + ((size_t)b * 64 * S + 256 * qb)) + wid * 64 + lane;
        wg_sync();
        tile_stream<4, 3>(0, t1,
            [&](int t, int slot) { stage_tile<8, 2>(lds + slot * TILE, kb0 + (size_t)t * 64 * NINP, NINP, vb0 + (size_t)t * 64 * NINP, NINP, wid, lane);
                __builtin_amdgcn_global_load_lds(mbase + (size_t)t * S * 2, (LAS unsigned*)(lds + slot * TILE + 16384 + wid * 256), 4, 0, 0); },
            [&](int t, int slot) {
                if (t <= cq) {
                    const LAS unsigned char* buf = lds + slot * TILE;
                    u32x2 mw; asm volatile("ds_read_b64 %0, %1 offset:16384\n\ts_waitcnt lgkmcnt(0)" : "=v"(mw) : "v"((unsigned)(unsigned long)(buf + (qg * 32 + r32) * 8)));
                    const unsigned wl = mw.x >> (4 * hi), wh = mw.y >> (4 * hi);
                    f32x16 p0, p1; const float dq = (float)(64 * t + 4 * hi - tq);
                    if (t == cq) {
#pragma unroll
                        for (int r = 0; r < 16; ++r) { const float c = (float)((r & 3) + 8 * (r >> 2)); p0[r] = fmaf(-slope2, fabsf(dq + c), -m); p1[r] = fmaf(-slope2, fabsf(dq + c + 32.0f), -m); }
                    } else { const float sb = slope2 * dq - m;
#pragma unroll
                        for (int r = 0; r < 16; ++r) { const float c = (float)((r & 3) + 8 * (r >> 2)); p0[r] = fmaf(slope2, c, sb); p1[r] = fmaf(slope2, c + 32.0f, sb); }
                    }
                    attn_step<64, 2, true>(buf, buf + 8192, qr, p0, p1, o, m, l, false, seen, lane, [wl, wh](f32x16& a, f32x16& bb) {
#pragma unroll
                        for (int r = 0; r < 16; ++r) { const int c = (r & 3) + 8 * (r >> 2);
                            const unsigned s0 = (unsigned)__builtin_amdgcn_sbfe((int)wl, c, 1), s1 = (unsigned)__builtin_amdgcn_sbfe((int)wh, c, 1);
                            a[r] = __uint_as_float((__float_as_uint(a[r]) & s0) | (0xF149F2CAu & ~s0)); bb[r] = __uint_as_float((__float_as_uint(bb[r]) & s1) | (0xF149F2CAu & ~s1)); } });
                } });
        l += __shfl_xor(l, 32); const float inv = 1.0f / l;
        bf16_t* orow = Y + (size_t)tok * D + 768 + h * 64;
#pragma unroll
        for (int db = 0; db < 2; ++db) store_o16(orow + db * 32, o[db], inv, hi);
    }
    wg_sync();
}

constexpr int NPHASES = 26;
__global__ void __launch_bounds__(512, 2) mega(Params p_unused) {
    CParams* const kp0 = (CParams*)__builtin_amdgcn_kernarg_segment_ptr();
#define p (*opqk(kp0))
    extern __shared__ __attribute__((aligned(16))) unsigned char lds_raw[];
    LAS unsigned char* ldsL = (LAS unsigned char*)lds_raw;
    float* ldsf = (float*)lds_raw;
    const int WIDS = __builtin_amdgcn_readfirstlane((int)threadIdx.x >> 6);
    const int tid = TIDX;
    for (int u = tid; u < (LDS_BYTES - LDS_MISC) / 4; u += 512) ((LAS unsigned*)(ldsL + LDS_MISC))[u] = 0u;
    __syncthreads();
    const int lo = p.ph_lo, hi = p.ph_hi; const bool one = (hi - lo) > 1;
    XcdBarrier bar; bar.bar = (unsigned*)(WSX + CT_BAR); bar.x = 0; bar.st = nullptr;
    if (one) bar = xcd_barrier_post((unsigned*)(WSX + CT_BAR), (volatile LAS unsigned*)(ldsL + LDS_MISC), WIDS);
    int ph = 0;
#define RUN (ph >= lo && ph < hi)
#define SEAM do { if (ph >= lo && ph + 1 < hi) xcd_barrier(bar, WIDS); ++ph; } while (0)
#define G GDIM
#define bid BIDX
#define vcu ((G % 8 == 0) ? (bid % 8) * (G / 8) + bid / 8 : bid)
#define B0 ((bf16_t*)(WSX + WS_B0))
#define B1 ((bf16_t*)(WSX + WS_B1))
#define BIG ((bf16_t*)(WSX + WS_BIG))
#define WSM ((bf16_t*)(WSX + WS_WSM))
#define WBIG ((bf16_t*)(WSX + WS_WBIG))

    if (RUN) { ph_prologue(p, WIDS); ph_prep_small(p, 0, ldsf, WIDS); }
    SEAM;
    for (int layer = 0; layer < 2; ++layer) {
        if (RUN) {
            { constexpr int KV_PM0 = (int)((WS_MEMB - WS_B0) / ((size_t)256 * D * 2)), KV_PN0 = (int)(WSM_WKV / ((size_t)256 * D));
              static_assert((WS_MEMB - WS_B0) % ((size_t)256 * D * 2) == 0 && WSM_WKV % ((size_t)256 * D) == 0, "KV tiles must sit on the tile grid of Hb / Win_t");
              pg8::Gemm g{B0, WSM + WSM_WIN, T, NINP, D}; pg8::ProjKvOrder so; so.init(T, NINP, G, bid, KV_PM0, KV_PN0);
              pg8::EpiProjKv E{BIG, NINP, (bf16_t*)(WSX + WS_KV), KV_PM0, KV_PN0};
              pg8::gemm_phase<pg8::EpiProjKv, pg8::ProjKvOrder, true, true>(ldsL, g, so, E, WIDS); }
        }
        SEAM;
        if (RUN) { ph_norms(p, layer, ldsL, WIDS); ph_d1(p, 0, ldsL, WIDS); }
        SEAM;
        if (RUN) { const int sub = p.sub; if (sub == 0 || sub == 1) ph_diff(p, layer, ldsL, WIDS); if (sub == 0 || sub == 2) ph_band(p, layer, ldsL, WIDS); if (sub == 0 || sub == 3) ph_d3(p, layer, ldsL, WIDS); }
        SEAM;
        if (RUN) { pg8::Gemm g{B1, WSM + WSM_WOUT, T, D, D}; pg8::StaticOrder so; so.init(T, D, G, bid); pg8::EpiResid E{B0, (bf16_t*)(WSX + WS_ZB)};
            pg8::gemm_phase<pg8::EpiResid, pg8::StaticOrder, true, true>(ldsL, g, so, E, WIDS); }
        SEAM;
        if (RUN) { if (p.sub != 7) ph_layernorm(p, asg(p.ln1g) + layer * D, asg(p.ln1b) + layer * D, WIDS); ph_prep_big(p, layer, ldsf, WIDS); }
        SEAM;
        if (RUN) {
            pg8::StaticOrder so; so.init(T, D, G, bid);
            { pg8::Gemm g{B0, WSM + WSM_WQ, T, D, D}; pg8::EpiStore E{BIG, D, 0};
              pg8::gemm_phase<pg8::EpiStore, pg8::StaticOrder, true, true>(ldsL, g, so, E, WIDS); }
            pg8::Unit u;
            for (int i = 0; so.next(i, u); ++i) { const int b = u.pm >> 4, qb0 = 2 * (u.pm & 15);
                for (int hq = 0; hq < 2; ++hq) cross_unit(p, ldsL, WIDS, b, u.pn, qb0 + hq); }
            __syncthreads();
        }
        SEAM;
        if (RUN) { pg8::Gemm g{B1, WSM + WSM_WO, T, D, D}; pg8::StaticOrder so; so.init(T, D, G, bid); pg8::EpiResid E{B0, (bf16_t*)(WSX + WS_ZB)};
            pg8::gemm_phase<pg8::EpiResid, pg8::StaticOrder, true, true>(ldsL, g, so, E, WIDS); }
        SEAM;
        if (RUN) { if (layer == 0) ph_layernorm(p, asg(p.ln2g) + layer * D, asg(p.ln2b) + layer * D, WIDS); else ph_ln_router(p, asg(p.ln2g) + layer * D, asg(p.ln2b) + layer * D, ldsL, WIDS); }
        SEAM;
        if (layer == 0) {
            if (RUN) { pg8::Gemm g{B0, WBIG, T, 2 * DFF, D}; pg8::StaticOrder so; so.init(T, 2 * DFF, G, bid); pg8::EpiSwiglu E{BIG, DFF, 0};
                pg8::gemm_phase<pg8::EpiSwiglu, pg8::StaticOrder, true, true>(ldsL, g, so, E, WIDS); }
            SEAM;
            if (RUN) { pg8::Gemm g{BIG, WBIG + WB_W2, T, D, DFF}; pg8::StaticOrder so; so.init(T, D, G, bid); pg8::EpiResid E{B0, (bf16_t*)(WSX + WS_ZB)};
                pg8::gemm_phase<pg8::EpiResid, pg8::StaticOrder, true, true>(ldsL, g, so, E, WIDS); }
            SEAM;
            if (RUN) { ph_layernorm(p, asg(p.ln3g) + layer * D, asg(p.ln3b) + layer * D, WIDS); ph_prep_small(p, 1, ldsf, WIDS); }
            SEAM;
        } else {
            if (RUN) ph_scatter(p, ldsL, WIDS);
            SEAM;
            for (int pass = 0; pass < 2; ++pass) {
                const int* cnt = (const int*)(WSX + CT_CNT); int nt = 0;
                for (int e = 0; e < 8; ++e) nt += (cnt[e] + 255) / 256;
                nt = __builtin_amdgcn_readfirstlane(nt);
                const int pstart = pass * 128; int nvalid = pass == 0 ? (nt < 128 ? nt : 128) : (nt - 128 < 0 ? 0 : nt - 128);
                const int* tile_e = (const int*)(WSX + CT_TILEE) + pstart;
                bf16_t* Xg = (bf16_t*)(WSX + WS_XG) + (size_t)pstart * 256 * D;
                if (RUN) { pg8::Gemm g{Xg, WBIG, PASS_ROWS, 2 * DFFE * NE, D}; pg8::MoeOrder mo{tile_e, nvalid, 2 * DFFE / 256, G, vcu}; pg8::EpiSwiglu E{BIG, DFFE, 2 * DFFE / 256};
                    pg8::gemm_phase<pg8::EpiSwiglu, pg8::MoeOrder, true, true>(ldsL, g, mo, E, WIDS); }
                SEAM;
                if (RUN) { pg8::Gemm g{BIG, WBIG + WB_W2E, PASS_ROWS, D * NE, DFFE}; pg8::MoeOrder mo{tile_e, nvalid, D / 256, G, vcu}; pg8::EpiStore E{Xg, D, D / 256};
                    pg8::gemm_phase<pg8::EpiStore, pg8::MoeOrder, true, true>(ldsL, g, mo, E, WIDS); }
                SEAM;
            }
            if (RUN) ph_combine_ln(p, asg(p.ln3g) + layer * D, asg(p.ln3b) + layer * D, WIDS);
            SEAM;
        }
    }
#undef RUN
#undef SEAM
#undef p
#undef G
#undef bid
#undef vcu
}

extern "C" void kernel_launch(void* const* d_in, const int* in_sizes, int n_in, void* d_out, int out_size, void* d_ws, size_t ws_size, hipStream_t stream) {
    static int grid = 0;
    if (grid == 0) {
        if (ws_size < WS_END || n_in < 27) { fprintf(stderr, "kernel_launch: workspace too small: %zu < %zu\n", ws_size, (size_t)WS_END); grid = -1; return; }
        int dev = 0, cus = 0;
        if (hipGetDevice(&dev) != hipSuccess || hipDeviceGetAttribute(&cus, hipDeviceAttributeMultiprocessorCount, dev) != hipSuccess) { grid = -1; return; }
        if (hipFuncSetAttribute((const void*)mega, hipFuncAttributeMaxDynamicSharedMemorySize, LDS_BYTES) != hipSuccess) { fprintf(stderr, "kernel_launch: hipFuncSetAttribute failed\n"); grid = -1; return; }
        int per_cu = 0; (void)hipOccupancyMaxActiveBlocksPerMultiprocessor(&per_cu, (const void*)mega, 512, LDS_BYTES); (void)hipGetLastError();
        if (per_cu < 1) fprintf(stderr, "kernel_launch: occupancy query says %d\n", per_cu);
        grid = cus;
    }
    if (grid < 0) return;
    (void)hipMemsetAsync((char*)d_ws + WS_CTL, 0, CTL_ZERO_BYTES, stream);
    Params p{};
    const float** pp = (const float**)&p;
    for (int i = 0; i < 27; ++i) pp[i] = (const float*)d_in[i];
    p.out = (float*)d_out; p.ws = (unsigned char*)d_ws;
#if MK_DUP_N > 0
    p.ph_lo = 0; p.ph_hi = MK_DUP_PH + 1; hipLaunchKernelGGL(mega, dim3(grid), dim3(512), LDS_BYTES, stream, p);
    for (int r = 0; r < MK_DUP_N; ++r) { (void)hipMemsetAsync((char*)d_ws + CT_QCTR, 0, 8192, stream); p.ph_lo = MK_DUP_PH; p.ph_hi = MK_DUP_PH + 1; p.sub = MK_DUP_SUB; hipLaunchKernelGGL(mega, dim3(grid), dim3(512), LDS_BYTES, stream, p); }
    p.sub = 0; p.ph_lo = MK_DUP_PH + 1; p.ph_hi = 1 << 20;
    (void)hipMemsetAsync((char*)d_ws + WS_CTL, 0, 16384, stream); (void)hipMemsetAsync((char*)d_ws + CT_QCTR + 4096, 0, 4096, stream);
    hipLaunchKernelGGL(mega, dim3(grid), dim3(512), LDS_BYTES, stream, p);
#elif MK_ONE_LAUNCH
    p.ph_lo = 0; p.ph_hi = 1 << 20;
    hipLaunchKernelGGL(mega, dim3(grid), dim3(512), LDS_BYTES, stream, p);
#else
    for (int k = 0; k < NPHASES; ++k) { p.ph_lo = k; p.ph_hi = k + 1; hipLaunchKernelGGL(mega, dim3(grid), dim3(512), LDS_BYTES, stream, p); }
#endif
}
```

```cpp
#include <hip/hip_runtime.h>
#include <stdint.h>
#include <stdio.h>
#define MK_ONE_LAUNCH 1
#define MK_DUP_PH 0
#define MK_DUP_N 0
#define MK_DUP_SUB 0

typedef uint16_t bf16_t;
#define LAS __attribute__((address_space(3)))
#define GAS __attribute__((address_space(1)))

constexpr int D = 1024, NB = 8, S = 4096, T = NB * S, NMEM = 256;
constexpr int NIN = 3656, NINP = 3840;
constexpr int OFF_QA = 0, OFF_KA = 512, OFF_VA = 1024, OFF_QB = 1536, OFF_KB = 1792, OFF_VB = 2048;
constexpr int OFF_QC = 2304, OFF_KC = 2560, OFF_VC = 2816, OFF_QI = 3072, OFF_KI = 3584, OFF_WI = 3648;
constexpr int DFF = 2816, NE = 8, DFFE = 3584;
constexpr float ALPHA = 1.41421356237f;
constexpr float LN_EPS = 1e-5f, RMS_EPS = 1e-6f;
constexpr float LOG2E = 1.4426950408889634f;
constexpr int MAXROWS = 2 * T + NE * 256;
constexpr int PASS_TILES = MAXROWS / 256 / 2;
constexpr int PASS_ROWS = PASS_TILES * 256;

constexpr size_t MiB = 1u << 20;
constexpr size_t WS_CTL = 0;
constexpr size_t WS_WSM = 2 * MiB;
constexpr size_t WS_WBIG = 20 * MiB;
constexpr size_t WS_BIG = 188 * MiB;
constexpr size_t WS_ZB = WS_BIG + 176 * MiB;
constexpr size_t WS_B0 = 428 * MiB;
constexpr size_t WS_B1 = 492 * MiB;
constexpr size_t WS_XG = WS_B0;
constexpr size_t WS_KV = 560 * MiB;
constexpr size_t WS_MEMB = 568 * MiB;
constexpr size_t WS_END = 572 * MiB;
constexpr size_t WSM_WIN = 0, WSM_WOUT = (size_t)NINP * D, WSM_WQ = WSM_WOUT + (size_t)D * D, WSM_WO = WSM_WQ + (size_t)D * D, WSM_WKV = WSM_WO + (size_t)D * D;
static_assert((WSM_WKV + 2 * (size_t)D * D) * 2 <= 18 * MiB, "wsm");
constexpr size_t ISC_BATCH = (size_t)4096 * 2080;
constexpr int ISC_IN_WBIG = 5;
constexpr size_t OUT_MASK = (size_t)3 * ISC_BATCH * 4;
static_assert((size_t)ISC_IN_WBIG * ISC_BATCH * 4 <= 168 * MiB && OUT_MASK + (size_t)T * 512 <= (size_t)T * D * 4, "isc scratch");
constexpr size_t CT_BAR = 0;
constexpr size_t CT_CNT = 32 * 1024;
constexpr size_t CT_QCTR = 36 * 1024;
constexpr size_t CT_NORM = 108 * 1024;
constexpr size_t CT_LAM = 64 * 1024;
constexpr size_t CT_TILEE = 66 * 1024;
constexpr size_t CT_E0 = 128 * 1024;
constexpr size_t CT_E1 = CT_E0 + T * 4;
constexpr size_t CT_G0 = CT_E1 + T * 4;
constexpr size_t CT_G1 = CT_G0 + T * 4;
constexpr size_t CT_P0 = CT_G1 + T * 4;
constexpr size_t CT_P1 = CT_P0 + T * 4;
constexpr size_t CT_ROWTOK = CT_P1 + T * 4;
static_assert(CT_ROWTOK + MAXROWS * 4 <= 2 * MiB, "ctl");
constexpr size_t CTL_ZERO_BYTES = 64 * 1024;

constexpr int LDS_BYTES = 147456;
constexpr int LDS_MISC = 131072;

struct Params {
    const float *x, *mem, *w_in, *lq1, *lk1, *lq2, *lk2, *dgain, *relb, *w_out, *ln1g, *ln1b, *wq, *wk, *wv, *wo, *ln2g, *ln2b,
        *fw1, *fw3, *fw2, *router, *mw1, *mw3, *mw2, *ln3g, *ln3b;
    float* out;
    unsigned char* ws;
    int ph_lo, ph_hi;
    int sub, pad_;
};

typedef const __attribute__((address_space(4))) Params CParams;
__device__ __forceinline__ CParams* opqk(CParams* x) { asm volatile("" : "+s"(x)); return x; }
typedef float f32x4 __attribute__((ext_vector_type(4)));
typedef unsigned u32x4 __attribute__((ext_vector_type(4)));
typedef unsigned u32x2 __attribute__((ext_vector_type(2)));

__device__ __forceinline__ float bf2f(bf16_t v) { return __uint_as_float(((unsigned)v) << 16); }
__device__ __forceinline__ bf16_t f2bf(float f) { unsigned u = __float_as_uint(f); return (bf16_t)((u + 0x7fffu + ((u >> 16) & 1u)) >> 16); }
__device__ __forceinline__ unsigned pk2(float lo, float hi) { typedef float f2 __attribute__((ext_vector_type(2))); typedef __bf16 b2 __attribute__((ext_vector_type(2)));
    f2 v = {lo, hi}; b2 b = __builtin_convertvector(v, b2); return __builtin_bit_cast(unsigned, b); }
__device__ __forceinline__ float ldA(const float* p) { return *p; }
__device__ __forceinline__ float ldA(const bf16_t* p) { return bf2f(*p); }
__device__ __forceinline__ float wave_max(float v) { for (int o = 32; o > 0; o >>= 1) v = fmaxf(v, __shfl_xor(v, o)); return v; }
__device__ __forceinline__ float wave_sum(float v) { for (int o = 32; o > 0; o >>= 1) v += __shfl_xor(v, o); return v; }

__device__ __forceinline__ int tid_of(int wids) { int t = (wids << 6) | (int)__builtin_amdgcn_mbcnt_hi(~0u, __builtin_amdgcn_mbcnt_lo(~0u, 0u)); asm volatile("" : "+v"(t)); return t; }
#define TIDX tid_of(WIDS)

__device__ __forceinline__ unsigned char* opq(unsigned char* x) { asm volatile("" : "+s"(x)); return x; }
template <typename T_> __device__ __forceinline__ T_* asg(T_* x) { return x; }
#define WSX asg(opq(p.ws))

__device__ __forceinline__ int opq_i(int x) { asm volatile("" : "+s"(x)); return x; }
#define BIDX opq_i((int)blockIdx.x)
#define GDIM opq_i((int)gridDim.x)

namespace pg8 {
#define PG8_LAS __attribute__((address_space(3)))
typedef unsigned short bf16_t;
typedef short bf16x8 __attribute__((ext_vector_type(8)));
typedef float f32x4 __attribute__((ext_vector_type(4)));
typedef unsigned u32x4 __attribute__((ext_vector_type(4)));
constexpr int BM = 256, BK = 64, HALF = 128, HTB = HALF * BK * 2  , STAGE_BYTES = 8 * HTB, NXCD = 8, WGM = 8;

__host__ __device__ __forceinline__ int lds_byte(int r, int c) { const int st = (r >> 4) * 2 + (c >> 5), rr = r & 15, cc = c & 31, ob = rr * 64 + cc * 2; return st * 1024 + (ob ^ (((ob >> 9) & 1) << 5)); }
__host__ __device__ __forceinline__ void stage_rc(int b, int& R, int& C) { const int st = b / 1024, sb = b % 1024, swz = sb ^ (((sb >> 9) & 1) << 5); R = (st >> 1) * 16 + swz / 64; C = (st & 1) * 32 + (swz % 64) / 2; }
__host__ __device__ __forceinline__ int perm32(int rho) { const int n = rho >> 4, i = rho & 15; return 8 * (i >> 2) + 4 * n + (i & 3); }

struct Unit { int pm, pn; };
struct Gemm { const bf16_t* A; const bf16_t* Bt; int M, N, K; };

struct StaticOrder {
    int nM, nN, nwg, G, c;
    __host__ __device__ void init(int M, int N, int G_, int c_) { nM = M / BM; nN = N / BM; nwg = nM * nN; G = G_; c = c_; }
    __host__ __device__ __forceinline__ bool next(int i, Unit& u) const {
        const long L = (long)i * G + c; if (L >= nwg) return false;
        int wgid = (int)L; { const int q = nwg / NXCD, r = nwg % NXCD, xcd = wgid % NXCD, off = wgid / NXCD; wgid = (xcd < r ? xcd * (q + 1) : r * (q + 1) + (xcd - r) * q) + off; }
        const int nig = WGM * nN, gid = wgid / nig, fm = gid * WGM, gsz = (nM - fm) < WGM ? (nM - fm) : WGM;
        u.pm = fm + ((wgid % nig) % gsz); u.pn = (wgid % nig) / gsz; return true;
    }
    __device__ __forceinline__ void a_ready(const Unit&) const {}
    __device__ __forceinline__ void done(const Unit&) const {}
};


struct MoeOrder {
    const int* tile_e; int nvalid, nN, G, c;
    __device__ bool next(int i, Unit& u) const {
        const long L = (long)i * G + c; if (L >= (long)nvalid * nN) return false;
        const int pm = (int)(L / nN), pn = (int)(L % nN); const int e = __builtin_amdgcn_readfirstlane(tile_e[pm]);
        u.pm = pm; u.pn = e * nN + pn; return true;
    }
    __device__ __forceinline__ void a_ready(const Unit&) const {}
    __device__ __forceinline__ void done(const Unit&) const {}
};
struct EpiStore {
    static constexpr bool PERM = true, AFTER_DRAIN = false;
    bf16_t* O; int ldc; int nN;
    __device__ __forceinline__ void operator()(const f32x4 (&acc)[2][2][4][2], const Unit& u, int wr, int wc, int fr, int fq) const {
        const int row0 = u.pm * BM + wr * 64 + fr; const int pn = nN ? (u.pn % nN) : u.pn; const int col0 = pn * BM + wc * 32 + 8 * fq;
#pragma unroll
        for (int ai = 0; ai < 2; ++ai)
#pragma unroll
            for (int m = 0; m < 4; ++m) { bf16_t* rowp = O + (size_t)(row0 + ai * HALF + m * 16) * ldc + col0;
#pragma unroll
                for (int bj = 0; bj < 2; ++bj) { const f32x4 v0 = acc[ai][bj][m][0], v1 = acc[ai][bj][m][1];
                    u32x4 w; w.x = ::pk2(v0[0], v0[1]); w.y = ::pk2(v0[2], v0[3]); w.z = ::pk2(v1[0], v1[1]); w.w = ::pk2(v1[2], v1[3]);
                    *(u32x4*)(rowp + bj * HALF) = w; } }
    }
};
struct ProjKvOrder {
    StaticOrder so; int nproj, ng, cc, kv_pm0, kv_pn0;
    __device__ void init(int M, int N, int g_, int c_, int pm0, int pn0) { so.init(M, N, g_, c_); nproj = (M / BM) * (N / BM); ng = g_; cc = c_; kv_pm0 = pm0; kv_pn0 = pn0; }
    __device__ bool next(int i, Unit& u) const {
        const long L = (long)i * ng + cc;
        if (L < nproj) return so.next(i, u);
        const int r = (int)(L - nproj); if (r >= 64) return false;
        u.pm = kv_pm0 + (r >> 3); u.pn = kv_pn0 + (r & 7); return true;
    }
    __device__ __forceinline__ void a_ready(const Unit&) const {}
    __device__ __forceinline__ void done(const Unit&) const {}
};
struct EpiProjKv {
    static constexpr bool PERM = true, AFTER_DRAIN = false;
    bf16_t* O; int ldc; bf16_t* O2; int kv_pm0, kv_pn0;
    __device__ __forceinline__ void operator()(const f32x4 (&acc)[2][2][4][2], const Unit& u, int wr, int wc, int fr, int fq) const {
        const bool kv = u.pm >= kv_pm0;
        bf16_t* base = kv ? O2 : O; const int ld = kv ? 2048 : ldc; const int pm = kv ? u.pm - kv_pm0 : u.pm, pn = kv ? u.pn - kv_pn0 : u.pn;
        const int row0 = pm * BM + wr * 64 + fr, col0 = pn * BM + wc * 32 + 8 * fq;
#pragma unroll
        for (int ai = 0; ai < 2; ++ai)
#pragma unroll
            for (int m = 0; m < 4; ++m) { bf16_t* rowp = base + (size_t)(row0 + ai * HALF + m * 16) * ld + col0;
#pragma unroll
                for (int bj = 0; bj < 2; ++bj) { const f32x4 v0 = acc[ai][bj][m][0], v1 = acc[ai][bj][m][1];
                    u32x4 w; w.x = ::pk2(v0[0], v0[1]); w.y = ::pk2(v0[2], v0[3]); w.z = ::pk2(v1[0], v1[1]); w.w = ::pk2(v1[2], v1[3]);
                    *(u32x4*)(rowp + bj * HALF) = w; } }
    }
};
struct EpiResid {
    static constexpr bool PERM = true, AFTER_DRAIN = false;
    const bf16_t* resid; bf16_t* out;
    __device__ __forceinline__ void operator()(const f32x4 (&acc)[2][2][4][2], const Unit& u, int wr, int wc, int fr, int fq) const {
        const int row0 = u.pm * BM + wr * 64 + fr, col0 = u.pn * BM + wc * 32 + 8 * fq;
#pragma unroll
        for (int ai = 0; ai < 2; ++ai)
#pragma unroll
            for (int m = 0; m < 4; ++m) { const size_t off = (size_t)(row0 + ai * HALF + m * 16) * 1024 + col0;
#pragma unroll
                for (int bj = 0; bj < 2; ++bj) { const size_t o = off + bj * HALF; const u32x4 rb = *(const u32x4*)(resid + o);
                    const f32x4 v0 = acc[ai][bj][m][0], v1 = acc[ai][bj][m][1]; const float A = 1.41421356237f;
                    u32x4 w;
                    w.x = ::pk2(__uint_as_float(rb.x << 16) * A + v0[0], __uint_as_float(rb.x & 0xffff0000u) * A + v0[1]);
                    w.y = ::pk2(__uint_as_float(rb.y << 16) * A + v0[2], __uint_as_float(rb.y & 0xffff0000u) * A + v0[3]);
                    w.z = ::pk2(__uint_as_float(rb.z << 16) * A + v1[0], __uint_as_float(rb.z & 0xffff0000u) * A + v1[1]);
                    w.w = ::pk2(__uint_as_float(rb.w << 16) * A + v1[2], __uint_as_float(rb.w & 0xffff0000u) * A + v1[3]);
                    *(u32x4*)(out + o) = w; } }
    }
};
struct EpiSwiglu {
    static constexpr bool PERM = true, AFTER_DRAIN = false;
    bf16_t* O; int ldc; int nN;
    static __device__ __forceinline__ float sg(float g, float u) { return g * __builtin_amdgcn_rcpf(1.0f + __builtin_amdgcn_exp2f(-1.4426950408889634f * g)) * u; }
    __device__ __forceinline__ void operator()(const f32x4 (&acc)[2][2][4][2], const Unit& u, int wr, int wc, int fr, int fq) const {
        const int row0 = u.pm * BM + wr * 64 + fr; const int pn = nN ? (u.pn % nN) : u.pn; const int col0 = pn * HALF + wc * 32 + 8 * fq;
#pragma unroll
        for (int ai = 0; ai < 2; ++ai)
#pragma unroll
            for (int m = 0; m < 4; ++m) { bf16_t* rowp = O + (size_t)(row0 + ai * HALF + m * 16) * ldc + col0;
                const f32x4 g0 = acc[ai][0][m][0], g1 = acc[ai][0][m][1], u0 = acc[ai][1][m][0], u1 = acc[ai][1][m][1];
                u32x4 w; w.x = ::pk2(sg(g0[0], u0[0]), sg(g0[1], u0[1])); w.y = ::pk2(sg(g0[2], u0[2]), sg(g0[3], u0[3]));
                w.z = ::pk2(sg(g1[0], u1[0]), sg(g1[1], u1[1])); w.w = ::pk2(sg(g1[2], u1[2]), sg(g1[3], u1[3]));
                *(u32x4*)rowp = w; }
    }
};

template <class Epi, class Sched, bool ALIGN_EPI = false, bool SP2 = false>
__device__ __forceinline__ void gemm_phase(PG8_LAS unsigned char* lds, const Gemm g, const Sched& S, const Epi& E, int WIDS) {
    int tid_ = ::tid_of(WIDS); asm volatile("" : "+v"(tid_));
    const int tid = tid_, wid = __builtin_amdgcn_readfirstlane(tid >> 6), lane = tid & 63, wr = wid >> 2, wc = wid & 3, fr = lane & 15, fq = lane >> 4;
    const int K = g.K, nt = K / BK;
    unsigned voffA[2], voffB[2];
#pragma unroll
    for (int i = 0; i < 2; ++i) { int R, C; stage_rc(tid * 16 + i * 8192, R, C); const int Rb = Epi::PERM ? ((R & ~31) + perm32(R & 31)) : R;
        voffA[i] = (unsigned)(R * K + C) * 2u; voffB[i] = (unsigned)(Rb * K + C) * 2u; }
    const size_t kstep = (size_t)(BK * 2);
    const size_t hstep = (size_t)HALF * K * 2;
    const size_t tstep = 2 * hstep;
    const unsigned ldsw = (unsigned)wid * 1024u;
    const int aoff = lds_byte(wr * 64 + fr, fq * 8), boff = lds_byte(wc * 32 + fr, fq * 8);
#define PG8_SA(b, h) (((b) * 2 + (h)) * HTB)
#define PG8_SB(b, h) ((4 + (b) * 2 + (h)) * HTB)
#define PG8_STAGE(bufoff, gbase, voff) do { _Pragma("unroll") for (int _i = 0; _i < 2; ++_i) \
        __builtin_amdgcn_global_load_lds((const unsigned*)((const char*)(gbase) + (voff)[_i]), (PG8_LAS unsigned*)(lds + (bufoff) + ldsw + _i * 8192), 16, 0, 0); } while (0)
#define PG8_LDA(dst, b, h) do { _Pragma("unroll") for (int m = 0; m < 4; ++m) _Pragma("unroll") for (int k = 0; k < 2; ++k) dst[m][k] = *(const PG8_LAS bf16x8*)(lds + PG8_SA(b, h) + aoff + m * 2048 + k * 1024); } while (0)
#define PG8_LDB(dst, b, h) do { _Pragma("unroll") for (int n = 0; n < 2; ++n) _Pragma("unroll") for (int k = 0; k < 2; ++k) dst[n][k] = *(const PG8_LAS bf16x8*)(lds + PG8_SB(b, h) + boff + n * 2048 + k * 1024); } while (0)
#define PG8_MMA(ai, bj, At, Bt) do { __builtin_amdgcn_s_setprio(1); _Pragma("unroll") for (int m = 0; m < 4; ++m) _Pragma("unroll") for (int n = 0; n < 2; ++n) _Pragma("unroll") for (int k = 0; k < 2; ++k) \
        acc[ai][bj][m][n] = __builtin_amdgcn_mfma_f32_16x16x32_bf16(Bt[n][k], At[m][k], acc[ai][bj][m][n], 0, 0, 0); __builtin_amdgcn_s_setprio(0); } while (0)
#define PG8_WAIT_V(n) asm volatile("s_waitcnt vmcnt(" #n ")" ::: "memory")
#define PG8_WAIT_L(n) asm volatile("s_waitcnt lgkmcnt(" #n ")" ::: "memory")
#define PG8_BAR __builtin_amdgcn_s_barrier()
#define PG8_SCHED __builtin_amdgcn_sched_barrier(0)
    Unit cur, nxt; int ui = 0;
    if (!S.next(0, cur)) return;
    f32x4 acc[2][2][4][2];
#pragma unroll
    for (int a = 0; a < 2; ++a)
#pragma unroll
        for (int b = 0; b < 2; ++b)
#pragma unroll
            for (int m = 0; m < 4; ++m)
#pragma unroll
                for (int n = 0; n < 2; ++n) acc[a][b][m][n] = (f32x4){0.f, 0.f, 0.f, 0.f};
    bf16x8 At[4][2], B0[2][2], B1[2][2];
    const char* cA = (const char*)g.A + (size_t)cur.pm * tstep; const char* cB = (const char*)g.Bt + (size_t)cur.pn * tstep;
    S.a_ready(cur);
    if constexpr (SP2) {
        PG8_STAGE(PG8_SB(0, 0), cB, voffB); PG8_STAGE(PG8_SB(0, 1), cB + hstep, voffB); PG8_STAGE(PG8_SA(0, 0), cA, voffA); PG8_STAGE(PG8_SA(0, 1), cA + hstep, voffA);
        if (wr == 1) PG8_BAR;
        PG8_WAIT_V(2); PG8_BAR;
        PG8_STAGE(PG8_SB(1, 0), cB + kstep, voffB); PG8_STAGE(PG8_SA(1, 0), cA + kstep, voffA); PG8_STAGE(PG8_SB(1, 1), cB + hstep + kstep, voffB);
        PG8_WAIT_V(6); PG8_BAR;
    } else {
        PG8_STAGE(PG8_SB(0, 0), cB, voffB); PG8_STAGE(PG8_SA(0, 0), cA, voffA); PG8_STAGE(PG8_SB(0, 1), cB + hstep, voffB); PG8_STAGE(PG8_SA(0, 1), cA + hstep, voffA);
        if (wr == 1) PG8_BAR;
        PG8_WAIT_V(4); PG8_BAR;
        PG8_STAGE(PG8_SB(1, 0), cB + kstep, voffB); PG8_STAGE(PG8_SA(1, 0), cA + kstep, voffA); PG8_STAGE(PG8_SB(1, 1), cB + hstep + kstep, voffB);
        PG8_WAIT_V(6); PG8_BAR;
    }
    for (;;) {
        const bool has_next = S.next(ui + 1, nxt);
        const char* nA = has_next ? (const char*)g.A + (size_t)nxt.pm * tstep : cA; const char* nB = has_next ? (const char*)g.Bt + (size_t)nxt.pn * tstep : cB;
        for (int t = 0; t < nt; t += 2) {
            const bool last = (t == nt - 2);
            const char* a1 = cA + (size_t)(t + 1) * kstep;
            const char* a2 = last ? nA : cA + (size_t)(t + 2) * kstep; const char* b2 = last ? nB : cB + (size_t)(t + 2) * kstep;
            const char* a3 = a2 + kstep; const char* b3 = b2 + kstep;
            if (last && has_next) S.a_ready(nxt);
            if constexpr (SP2) {
            PG8_LDB(B0, 0, 0); PG8_LDB(B1, 0, 1); PG8_SCHED; PG8_LDA(At, 0, 0); PG8_STAGE(PG8_SA(1, 1), a1 + hstep, voffA);
            PG8_WAIT_V(8); PG8_WAIT_L(0); PG8_BAR; PG8_MMA(0, 0, At, B0); PG8_MMA(0, 1, At, B1); PG8_BAR; PG8_SCHED;
            PG8_LDA(At, 0, 1); PG8_STAGE(PG8_SB(0, 0), b2, voffB); PG8_STAGE(PG8_SB(0, 1), b2 + hstep, voffB); PG8_STAGE(PG8_SA(0, 0), a2, voffA);
            PG8_WAIT_V(8); PG8_WAIT_L(0); PG8_BAR; PG8_MMA(1, 0, At, B0); PG8_MMA(1, 1, At, B1); PG8_BAR; PG8_SCHED;
            PG8_LDB(B0, 1, 0); PG8_LDB(B1, 1, 1); PG8_SCHED; PG8_LDA(At, 1, 0); PG8_STAGE(PG8_SA(0, 1), a2 + hstep, voffA);
            PG8_WAIT_V(8); PG8_WAIT_L(0); PG8_BAR; PG8_MMA(0, 0, At, B0); PG8_MMA(0, 1, At, B1); PG8_BAR; PG8_SCHED;
            PG8_LDA(At, 1, 1); PG8_STAGE(PG8_SB(1, 0), b3, voffB); PG8_STAGE(PG8_SB(1, 1), b3 + hstep, voffB); PG8_STAGE(PG8_SA(1, 0), a3, voffA);
            PG8_WAIT_V(8); PG8_WAIT_L(0); PG8_BAR; PG8_MMA(1, 0, At, B0); PG8_MMA(1, 1, At, B1); PG8_BAR; PG8_SCHED;
            } else {
            PG8_LDB(B0, 0, 0); PG8_SCHED; PG8_LDA(At, 0, 0); PG8_STAGE(PG8_SA(1, 1), a1 + hstep, voffA);
            PG8_WAIT_L(8); PG8_BAR; PG8_WAIT_L(0); PG8_MMA(0, 0, At, B0); PG8_BAR; PG8_SCHED;
            PG8_LDB(B1, 0, 1); PG8_STAGE(PG8_SB(0, 0), b2, voffB);
            PG8_BAR; PG8_WAIT_L(0); PG8_MMA(0, 1, At, B1); PG8_BAR;
            PG8_LDA(At, 0, 1); PG8_STAGE(PG8_SA(0, 0), a2, voffA);
            PG8_BAR; PG8_WAIT_L(0); PG8_MMA(1, 0, At, B0); PG8_BAR; PG8_SCHED;
            PG8_STAGE(PG8_SB(0, 1), b2 + hstep, voffB);
            PG8_WAIT_V(6); PG8_BAR; PG8_MMA(1, 1, At, B1); PG8_BAR;
            PG8_LDB(B0, 1, 0); PG8_SCHED; PG8_LDA(At, 1, 0); PG8_STAGE(PG8_SA(0, 1), a2 + hstep, voffA);
            PG8_WAIT_L(8); PG8_BAR; PG8_WAIT_L(0); PG8_MMA(0, 0, At, B0); PG8_BAR; PG8_SCHED;
            PG8_LDB(B1, 1, 1); PG8_STAGE(PG8_SB(1, 0), b3, voffB);
            PG8_BAR; PG8_WAIT_L(0); PG8_MMA(0, 1, At, B1); PG8_BAR;
            PG8_LDA(At, 1, 1); PG8_STAGE(PG8_SA(1, 0), a3, voffA);
            PG8_BAR; PG8_WAIT_L(0); PG8_MMA(1, 0, At, B0); PG8_BAR; PG8_SCHED;
            PG8_STAGE(PG8_SB(1, 1), b3 + hstep, voffB);
            PG8_WAIT_V(6); PG8_BAR; PG8_MMA(1, 1, At, B1); PG8_BAR;
            }
        }
        if constexpr (ALIGN_EPI) { if (wr == 0) PG8_BAR; }
        if constexpr (!Epi::AFTER_DRAIN) { E(acc, cur, wr, wc, fr, fq); S.done(cur); }
        if (!has_next) break;
#pragma unroll
        for (int a = 0; a < 2; ++a)
#pragma unroll
            for (int b = 0; b < 2; ++b)
#pragma unroll
                for (int m = 0; m < 4; ++m)
#pragma unroll
                    for (int n = 0; n < 2; ++n) acc[a][b][m][n] = (f32x4){0.f, 0.f, 0.f, 0.f};
        cur = nxt; cA = nA; cB = nB; ++ui;
        if constexpr (ALIGN_EPI) { if (wr == 1) PG8_BAR; }
    }
    PG8_WAIT_V(0);
    if constexpr (!ALIGN_EPI) { if (wr == 0) PG8_BAR; }
    PG8_BAR;
    if constexpr (Epi::AFTER_DRAIN) { E.fused(acc, cur, wr, wc, fr, fq, lds, wid, lane); S.done(cur); }
#undef PG8_SA
#undef PG8_SB
#undef PG8_STAGE
#undef PG8_LDA
#undef PG8_LDB
#undef PG8_MMA
#undef PG8_WAIT_V
#undef PG8_WAIT_L
#undef PG8_BAR
#undef PG8_SCHED
}
}

#define XB_TMO      128
#define XB_XCNT(j)  (256  + 64 * (j))
#define XB_XSUB(j)  (1280 + 64 * (j))
#define XB_XGEN(j)  (2304 + 64 * (j))
#define XB_TOP      3328
#define XB_TOPGEN   3392
#define XCD_BAR_WORDS 3456
#define XB_SPIN_CAP (1u << 18)

__device__ __forceinline__ unsigned xb_ld(unsigned* p)              { return __hip_atomic_load(p, __ATOMIC_RELAXED, __HIP_MEMORY_SCOPE_AGENT); }
__device__ __forceinline__ unsigned xb_add(unsigned* p, unsigned v) { return __hip_atomic_fetch_add(p, v, __ATOMIC_RELAXED, __HIP_MEMORY_SCOPE_AGENT); }
__device__ __forceinline__ unsigned xb_xcc_id() { return (unsigned)__builtin_amdgcn_s_getreg((3 << 11) | 20) & 0xFu; }
#define XB_SPIN(cond, bar) do { unsigned _sp = 0; while (cond) { __builtin_amdgcn_s_sleep(1); \
    if ((++_sp & 255u) == 0u) { if (xb_ld(&(bar)[XB_TMO])) break; if (_sp > XB_SPIN_CAP) { atomicAdd(&(bar)[XB_TMO], 1u); break; } } } } while (0)

struct XcdBarrier {
    unsigned* bar; unsigned x;
    volatile LAS unsigned* st;
};

__device__ __forceinline__ XcdBarrier xcd_barrier_post(unsigned* bar, volatile LAS unsigned* st, int WIDS) {
    XcdBarrier b; b.bar = bar; b.x = xb_xcc_id(); b.st = st;
    if (tid_of(WIDS) == 0) (void)xb_add(&bar[XB_XCNT(b.x)], 1u);
    return b;
}
__device__ __forceinline__ void xcd_barrier_complete(unsigned* bar, unsigned x, unsigned& nloc, unsigned& nx) {
    const unsigned G = gridDim.x * gridDim.y * gridDim.z;
    unsigned sum, cnt, mine, sp = 0u;
    for (;;) {
        sum = 0u; cnt = 0u; mine = 0u;
#pragma unroll
        for (unsigned j = 0; j < 16; ++j) { const unsigned c = xb_ld(&bar[XB_XCNT(j)]); sum += c; cnt += (c > 0u) ? 1u : 0u; mine = (j == x) ? c : mine; }
        if (sum == G) break;
        __builtin_amdgcn_s_sleep(1);
        if ((++sp & 255u) == 0u) { if (xb_ld(&bar[XB_TMO])) break; if (sp > XB_SPIN_CAP) { atomicAdd(&bar[XB_TMO], 1u); break; } }
    }
    nloc = mine > 0u ? mine : 1u; nx = cnt > 0u ? cnt : 1u;
}

__device__ __forceinline__ void xcd_barrier(const XcdBarrier& b, int WIDS) {
    asm volatile("s_waitcnt vmcnt(0)" ::: "memory");
    __syncthreads();
    if (tid_of(WIDS) == 0) {
        unsigned* bar = b.bar;
        __builtin_amdgcn_s_waitcnt(0);
        unsigned nloc = b.st[0], nx = b.st[1];
        if (nloc == 0u) { xcd_barrier_complete(bar, b.x, nloc, nx); b.st[0] = nloc; b.st[1] = nx; }
        const unsigned old = xb_add(&bar[XB_XSUB(b.x)], 1u);
        const unsigned gen = old / nloc;
        if (old + 1u == (gen + 1u) * nloc) {
            __builtin_amdgcn_fence(__ATOMIC_RELEASE, "agent");
            asm volatile("s_waitcnt vmcnt(0)" ::: "memory");
            const unsigned og = xb_add(&bar[XB_TOP], 1u);
            const unsigned tg = og / nx;
            if (og + 1u == (tg + 1u) * nx) xb_add(&bar[XB_TOPGEN], 1u);
            else XB_SPIN(xb_ld(&bar[XB_TOPGEN]) == tg, bar);
            __builtin_amdgcn_fence(__ATOMIC_ACQUIRE, "agent");
            xb_add(&bar[XB_XGEN(b.x)], 1u);
            asm volatile("s_waitcnt vmcnt(0)" ::: "memory");
        } else {
            XB_SPIN(xb_ld(&bar[XB_XGEN(b.x)]) == gen, bar);
            __builtin_amdgcn_fence(__ATOMIC_ACQUIRE, "agent");
            asm volatile("s_waitcnt vmcnt(0)" ::: "memory");
        }
    }
    __syncthreads();
}

struct CvtJob { const float* src; bf16_t* dst; int K, N, Npad, G, gstride, off; };
__device__ __forceinline__ void cvt_job(const CvtJob j, float* tile  , int WIDS, int& rr) {
    const int tid = TIDX, nkt = j.K / 64, nnt = j.Npad / 256, G = GDIM, nit = nkt * nnt;
    for (int item = (BIDX + G - rr % G) % G; item < nit; item += G) {
        const int kt = item % nkt, nt = item / nkt, k0 = kt * 64, n0 = nt * 256;
        f32x4 v[8];
        { const int n = (tid & 63) * 4; const float* sp = j.src + (size_t)(k0 + (tid >> 6)) * j.N + n0 + n; const bool ok = n0 + n < j.N;
#pragma unroll
          for (int q = 0; q < 8; ++q) { v[q] = (f32x4){0.f, 0.f, 0.f, 0.f}; if (ok) v[q] = *(const f32x4*)(sp + (size_t)(8 * q) * j.N); } }
        __syncthreads();
        { float* tp = tile + (tid >> 6) * 257 + (tid & 63) * 4;
#pragma unroll
          for (int q = 0; q < 8; ++q) { tp[q * 8 * 257] = v[q][0]; tp[q * 8 * 257 + 1] = v[q][1]; tp[q * 8 * 257 + 2] = v[q][2]; tp[q * 8 * 257 + 3] = v[q][3]; } }
        __syncthreads();
#pragma unroll
        for (int ps = 0; ps < 4; ++ps) {
            const int jb = tid + 512 * ps, n = jb >> 3, kc = (jb & 7) * 8, ng = n0 + n; const float* tr = tile + kc * 257 + n;
            u32x4 w; w.x = pk2(tr[0], tr[257]); w.y = pk2(tr[2 * 257], tr[3 * 257]); w.z = pk2(tr[4 * 257], tr[5 * 257]); w.w = pk2(tr[6 * 257], tr[7 * 257]);
            const size_t row = (size_t)(ng / j.G) * j.gstride + j.off + (ng % j.G);
            *(u32x4*)(j.dst + row * j.K + k0 + kc) = w;
        }
    }
    rr += nit;
}
constexpr int GID = 1 << 30;

__device__ __forceinline__ void ph_prologue(CParams& p, int WIDS) {
    bf16_t* Hb = (bf16_t*)(WSX + WS_B0); bf16_t* Mb = (bf16_t*)(WSX + WS_MEMB);
    const size_t g = (size_t)BIDX * 512 + TIDX, gs = (size_t)GDIM * 512;
    for (size_t i = g; i < (size_t)T * D / 4; i += gs) { const f32x4 v = ((const f32x4*)asg(p.x))[i]; u32x2 w; w.x = pk2(v[0], v[1]); w.y = pk2(v[2], v[3]); ((u32x2*)Hb)[i] = w; }
    for (size_t i = g; i < (size_t)NB * NMEM * D / 4; i += gs) { const f32x4 v = ((const f32x4*)asg(p.mem))[i]; u32x2 w; w.x = pk2(v[0], v[1]); w.y = pk2(v[2], v[3]); ((u32x2*)Mb)[i] = w; }
    if (BIDX == 0 && TIDX < 2) {
        const int l = TIDX; float a = 0.f, b = 0.f;
        for (int i = 0; i < 64; ++i) { a += asg(p.lq1)[l * 64 + i] * asg(p.lk1)[l * 64 + i]; b += asg(p.lq2)[l * 64 + i] * asg(p.lk2)[l * 64 + i]; }
        const float lam_init = 0.8f - 0.6f * expf(-0.3f * (float)l);
        float* lam = (float*)(WSX + CT_LAM); lam[l * 2] = expf(a) - expf(b) + lam_init; lam[l * 2 + 1] = lam_init;
    }
}
__device__ __forceinline__ void ph_prep_small(CParams& p, int layer, float* lds, int WIDS) {
    int rr = 0;
    bf16_t* W = (bf16_t*)(WSX + WS_WSM); const size_t DD = (size_t)D * D;
    cvt_job(CvtJob{asg(p.w_in) + (size_t)layer * D * NIN, W + WSM_WIN, D, NIN, NINP, GID, 0, 0}, lds, WIDS, rr);
    cvt_job(CvtJob{asg(p.w_out) + layer * DD, W + WSM_WOUT, D, D, D, GID, 0, 0}, lds, WIDS, rr);
    cvt_job(CvtJob{asg(p.wq) + layer * DD, W + WSM_WQ, D, D, D, GID, 0, 0}, lds, WIDS, rr);
    cvt_job(CvtJob{asg(p.wo) + layer * DD, W + WSM_WO, D, D, D, GID, 0, 0}, lds, WIDS, rr);
    cvt_job(CvtJob{asg(p.wk) + layer * DD, W + WSM_WKV, D, D, D, GID, 0, 0}, lds, WIDS, rr);
    cvt_job(CvtJob{asg(p.wv) + layer * DD, W + WSM_WKV + DD, D, D, D, GID, 0, 0}, lds, WIDS, rr);
}
constexpr size_t WB_W2 = (size_t)2 * DFF * D;
constexpr size_t WB_W2E = (size_t)NE * 2 * DFFE * D;
__device__ __forceinline__ void ph_prep_big(CParams& p, int layer, float* lds, int WIDS) {
    bf16_t* W = (bf16_t*)(WSX + WS_WBIG); int rr = 0;
    if (layer == 0) {
        cvt_job(CvtJob{asg(p.fw1), W, D, DFF, DFF, 128, 256, 0}, lds, WIDS, rr);
        cvt_job(CvtJob{asg(p.fw3), W, D, DFF, DFF, 128, 256, 128}, lds, WIDS, rr);
        cvt_job(CvtJob{asg(p.fw2), W + WB_W2, DFF, D, D, GID, 0, 0}, lds, WIDS, rr);
    } else {
        for (int e = 0; e < NE; ++e) {
            cvt_job(CvtJob{asg(p.mw1) + (size_t)e * D * DFFE, W + (size_t)e * 2 * DFFE * D, D, DFFE, DFFE, 128, 256, 0}, lds, WIDS, rr);
            cvt_job(CvtJob{asg(p.mw3) + (size_t)e * D * DFFE, W + (size_t)e * 2 * DFFE * D, D, DFFE, DFFE, 128, 256, 128}, lds, WIDS, rr);
            cvt_job(CvtJob{asg(p.mw2) + (size_t)e * DFFE * D, W + WB_W2E + (size_t)e * D * DFFE, DFFE, D, D, GID, 0, 0}, lds, WIDS, rr);
        }
    }
}

__device__ __forceinline__ void ph_layernorm(CParams& p, const float* g, const float* b, int WIDS) {
    const bf16_t* X = (const bf16_t*)(WSX + WS_ZB); bf16_t* Hb = (bf16_t*)(WSX + WS_B0);
    const int lane = TIDX & 63, w = TIDX >> 6;
    f32x4 gv[4], bv[4];
#pragma unroll
    for (int j = 0; j < 4; ++j) { gv[j] = ((const f32x4*)g)[64 * j + lane]; bv[j] = ((const f32x4*)b)[64 * j + lane]; }
    for (int row = BIDX * 8 + w; row < T; row += GDIM * 8) {
        const u32x2* xr = (const u32x2*)(X + (size_t)row * D) + lane; f32x4 v[4]; float s = 0.f;
#pragma unroll
        for (int j = 0; j < 4; ++j) { const u32x2 z = xr[64 * j]; v[j] = (f32x4){__uint_as_float(z.x << 16), __uint_as_float(z.x & 0xffff0000u), __uint_as_float(z.y << 16), __uint_as_float(z.y & 0xffff0000u)}; s += (v[j][0] + v[j][1]) + (v[j][2] + v[j][3]); }
        const float mu = wave_sum(s) * (1.0f / D); float q = 0.f;
#pragma unroll
        for (int j = 0; j < 4; ++j) { v[j] = v[j] - mu; q += (v[j][0] * v[j][0] + v[j][1] * v[j][1]) + (v[j][2] * v[j][2] + v[j][3] * v[j][3]); }
        const float rstd = rsqrtf(wave_sum(q) * (1.0f / D) + LN_EPS);
        u32x2* hb = (u32x2*)(Hb + (size_t)row * D) + lane;
#pragma unroll
        for (int j = 0; j < 4; ++j) { const f32x4 y = v[j] * rstd * gv[j] + bv[j]; u32x2 w2; w2.x = pk2(y[0], y[1]); w2.y = pk2(y[2], y[3]); hb[64 * j] = w2; }
    }
}
constexpr size_t CT_BLKCNT = 96 * 1024;
__device__ __forceinline__ void ph_ln_router(CParams& p, const float* g, const float* b, LAS unsigned char* lds, int WIDS) {
    float* X = asg(p.out); const bf16_t* Z = (const bf16_t*)(WSX + WS_ZB); const int tid = TIDX, lane = tid & 63, w = tid >> 6, bid = BIDX, G = GDIM, TPB = (T + G - 1) / G;
    int* e0 = (int*)(WSX + CT_E0); int* e1 = (int*)(WSX + CT_E1); float* g0 = (float*)(WSX + CT_G0); float* g1 = (float*)(WSX + CT_G1);
    LAS float* R = (LAS float*)lds;
    LAS int* lc = (LAS int*)(lds + 32768);
    __syncthreads();
    for (int i = tid; i < 8 * D; i += 512) R[(i & 7) * D + (i >> 3)] = asg(p.router)[i];
    if (tid < 8) lc[tid] = 0;
    __syncthreads();
    f32x4 gv[4], bv[4];
#pragma unroll
    for (int j = 0; j < 4; ++j) { gv[j] = ((const f32x4*)g)[64 * j + lane]; bv[j] = ((const f32x4*)b)[64 * j + lane]; }
    for (int tl = w; tl < TPB; tl += 8) {
        const int row = bid * TPB + tl; if (row >= T) break;
        f32x4* xr = (f32x4*)(X + (size_t)row * D) + lane; const u32x2* zr = (const u32x2*)(Z + (size_t)row * D) + lane; f32x4 v[4]; float s = 0.f;
#pragma unroll
        for (int j = 0; j < 4; ++j) { const u32x2 z = zr[64 * j]; v[j] = (f32x4){__uint_as_float(z.x << 16), __uint_as_float(z.x & 0xffff0000u), __uint_as_float(z.y << 16), __uint_as_float(z.y & 0xffff0000u)}; s += (v[j][0] + v[j][1]) + (v[j][2] + v[j][3]); }
        const float mu = wave_sum(s) * (1.0f / D); float q = 0.f;
#pragma unroll
        for (int j = 0; j < 4; ++j) { v[j] = v[j] - mu; q += (v[j][0] * v[j][0] + v[j][1] * v[j][1]) + (v[j][2] * v[j][2] + v[j][3] * v[j][3]); }
        const float rstd = rsqrtf(wave_sum(q) * (1.0f / D) + LN_EPS);
#pragma unroll
        for (int j = 0; j < 4; ++j) { v[j] = v[j] * rstd * gv[j] + bv[j]; xr[64 * j] = v[j]; }
        float lg[8];
#pragma unroll
        for (int e = 0; e < 8; ++e) { float a = 0.f;
#pragma unroll
            for (int j = 0; j < 4; ++j) { const f32x4 r = *(const LAS f32x4*)(R + e * D + 256 * j + 4 * lane); a += (v[j][0] * r[0] + v[j][1] * r[1]) + (v[j][2] * r[2] + v[j][3] * r[3]); }
            lg[e] = wave_sum(a); }
        if (lane == 0) {
            int i0 = 0; float b0 = lg[0];
#pragma unroll
            for (int e = 1; e < 8; ++e) if (lg[e] > b0) { b0 = lg[e]; i0 = e; }
            int i1 = -1; float b1 = -INFINITY;
#pragma unroll
            for (int e = 0; e < 8; ++e) if (e != i0 && lg[e] > b1) { b1 = lg[e]; i1 = e; }
            const float a = 1.0f / (1.0f + expf(b1 - b0));
            e0[row] = i0; e1[row] = i1; g0[row] = a; g1[row] = 1.0f - a;
            (void)__hip_atomic_fetch_add(lc + i0, 1, __ATOMIC_RELAXED, __HIP_MEMORY_SCOPE_WORKGROUP); (void)__hip_atomic_fetch_add(lc + i1, 1, __ATOMIC_RELAXED, __HIP_MEMORY_SCOPE_WORKGROUP);
        }
    }
    __syncthreads();
    if (tid < 8) ((int*)(WSX + CT_BLKCNT))[bid * 8 + tid] = lc[tid];
    __syncthreads();
}
__device__ __forceinline__ void ph_scatter(CParams& p, LAS unsigned char* lds, int WIDS) {
    const int tid = TIDX, lane = tid & 63, w = tid >> 6, bid = BIDX, G = GDIM, TPB = (T + G - 1) / G;
    const int* blk = (const int*)(WSX + CT_BLKCNT); int* cnt = (int*)(WSX + CT_CNT);
    LAS int* tot = (LAS int*)lds; LAS int* pre = tot + 8; LAS int* off = pre + 8;
    __syncthreads();
    { int t = 0, pb = 0; for (int bb = lane; bb < G; bb += 64) { const int c = blk[bb * 8 + w]; t += c; if (bb < bid) pb += c; }
#pragma unroll
      for (int o = 32; o > 0; o >>= 1) { t += __shfl_xor(t, o); pb += __shfl_xor(pb, o); }
      if (lane == 0) { tot[w] = t; pre[w] = pb; } }
    __syncthreads();
    if (tid == 0) { int o = 0; for (int e = 0; e < 8; ++e) { off[e] = o; o += ((tot[e] + 255) / 256) * 256; } off[8] = o; }
    __syncthreads();
    if (bid == 0) { int* tile_e = (int*)(WSX + CT_TILEE); if (tid < 8) cnt[tid] = tot[tid];
        for (int i = tid; i < MAXROWS / 256; i += 512) { int e = -1; for (int q = 0; q < 8; ++q) if (i * 256 >= off[q] && i * 256 < off[q + 1]) e = q; tile_e[i] = e; } }
    const int* e0 = (const int*)(WSX + CT_E0); const int* e1 = (const int*)(WSX + CT_E1);
    int* p0 = (int*)(WSX + CT_P0); int* p1 = (int*)(WSX + CT_P1);
    LAS int* posl = off + 16;
    int running = off[w] + pre[w];
    for (int n0 = 0; n0 < 2 * TPB; n0 += 64) {
        const int n = n0 + lane, tok = bid * TPB + (n >> 1), slot = n & 1;
        const bool ok = (n < 2 * TPB) && tok < T; const int e = ok ? (slot ? e1[tok] : e0[tok]) : -1;
        const unsigned long long m = __ballot(e == w);
        if (e == w) { const int pos = running + __popcll(m & ((1ull << lane) - 1ull)); if (slot) p1[tok] = pos; else p0[tok] = pos; posl[n] = pos; }
        running += __popcll(m);
    }
    __syncthreads();
    bf16_t* Xg = (bf16_t*)(WSX + WS_XG); const float* H = asg(p.out);
    for (int tl = w; tl < TPB; tl += 8) {
        const int tok = bid * TPB + tl; if (tok >= T) break;
        const f32x4* h = (const f32x4*)(H + (size_t)tok * D) + lane;
        u32x2* o0 = (u32x2*)(Xg + (size_t)posl[2 * tl] * D) + lane; u32x2* o1 = (u32x2*)(Xg + (size_t)posl[2 * tl + 1] * D) + lane;
#pragma unroll
        for (int j = 0; j < 4; ++j) { const f32x4 v = h[64 * j]; u32x2 w2; w2.x = pk2(v[0], v[1]); w2.y = pk2(v[2], v[3]); o0[64 * j] = w2; o1[64 * j] = w2; }
    }
    for (int e = 0; e < 8; ++e)
        for (int r = off[e] + tot[e] + bid * 8 + w; r < off[e + 1]; r += G * 8) { u32x2* o = (u32x2*)(Xg + (size_t)r * D) + lane;
#pragma unroll
            for (int j = 0; j < 4; ++j) { u32x2 z; z.x = 0u; z.y = 0u; o[64 * j] = z; } }
    __syncthreads();
}
__device__ __forceinline__ void ph_combine_ln(CParams& p, const float* g, const float* b, int WIDS) {
    const bf16_t* Yr = (const bf16_t*)(WSX + WS_XG); float* X = asg(p.out);
    const int* p0 = (const int*)(WSX + CT_P0); const int* p1 = (const int*)(WSX + CT_P1); const float* g0 = (const float*)(WSX + CT_G0); const float* g1 = (const float*)(WSX + CT_G1);
    const int lane = TIDX & 63, w = TIDX >> 6;
    f32x4 gv[4], bv[4];
#pragma unroll
    for (int j = 0; j < 4; ++j) { gv[j] = ((const f32x4*)g)[64 * j + lane]; bv[j] = ((const f32x4*)b)[64 * j + lane]; }
    for (int tok = BIDX * 8 + w; tok < T; tok += GDIM * 8) {
        const u32x2* ya = (const u32x2*)(Yr + (size_t)p0[tok] * D) + lane; const u32x2* yb = (const u32x2*)(Yr + (size_t)p1[tok] * D) + lane; const float ga = g0[tok], gb = g1[tok];
        f32x4* xr = (f32x4*)(X + (size_t)tok * D) + lane; f32x4 v[4]; float s = 0.f;
#pragma unroll
        for (int j = 0; j < 4; ++j) { const f32x4 h = xr[64 * j]; const u32x2 a = ya[64 * j], c = yb[64 * j];
            f32x4 fa = {__uint_as_float(a.x << 16), __uint_as_float(a.x & 0xffff0000u), __uint_as_float(a.y << 16), __uint_as_float(a.y & 0xffff0000u)};
            f32x4 fc = {__uint_as_float(c.x << 16), __uint_as_float(c.x & 0xffff0000u), __uint_as_float(c.y << 16), __uint_as_float(c.y & 0xffff0000u)};
            v[j] = h * ALPHA + fa * ga + fc * gb; s += (v[j][0] + v[j][1]) + (v[j][2] + v[j][3]); }
        const float mu = wave_sum(s) * (1.0f / D); float q = 0.f;
#pragma unroll
        for (int j = 0; j < 4; ++j) { v[j] = v[j] - mu; q += (v[j][0] * v[j][0] + v[j][1] * v[j][1]) + (v[j][2] * v[j][2] + v[j][3] * v[j][3]); }
        const float rstd = rsqrtf(wave_sum(q) * (1.0f / D) + LN_EPS);
#pragma unroll
        for (int j = 0; j < 4; ++j) xr[64 * j] = v[j] * rstd * gv[j] + bv[j];
    }
}

typedef short bf16x8 __attribute__((ext_vector_type(8)));
typedef short s16x4 __attribute__((ext_vector_type(4)));
typedef float f32x16 __attribute__((ext_vector_type(16)));
typedef short v4i16_t __attribute__((ext_vector_type(4)));
#define MFMA32(a, b, c) __builtin_amdgcn_mfma_f32_32x32x16_bf16((a), (b), (c), 0, 0, 0)
__device__ __forceinline__ s16x4 vtr(const LAS unsigned char* p) { return __builtin_bit_cast(s16x4, __builtin_amdgcn_ds_read_tr16_b64_v4i16((LAS v4i16_t*)p)); }
__device__ __forceinline__ bf16x8 pack8(float a0, float a1, float a2, float a3, float a4, float a5, float a6, float a7) {
    u32x4 w; w.x = pk2(a0, a1); w.y = pk2(a2, a3); w.z = pk2(a4, a5); w.w = pk2(a6, a7); return __builtin_bit_cast(bf16x8, w); }
__device__ __forceinline__ bf16x8 scale8(u32x4 q, float c) {
    return pack8(__uint_as_float(q.x << 16) * c, __uint_as_float(q.x & 0xffff0000u) * c, __uint_as_float(q.y << 16) * c, __uint_as_float(q.y & 0xffff0000u) * c,
                 __uint_as_float(q.z << 16) * c, __uint_as_float(q.z & 0xffff0000u) * c, __uint_as_float(q.w << 16) * c, __uint_as_float(q.w & 0xffff0000u) * c); }
__device__ __forceinline__ void wg_sync() { asm volatile("s_waitcnt vmcnt(0) lgkmcnt(0)" ::: "memory"); __builtin_amdgcn_s_barrier(); asm volatile("" ::: "memory"); }

__device__ __forceinline__ void glds16(const void* gsrc, unsigned lds_dst) { unsigned keep; const unsigned d = __builtin_amdgcn_readfirstlane(lds_dst);
    asm volatile("s_mov_b32 %0, m0\n\ts_mov_b32 m0, %2\n\ts_nop 0\n\tglobal_load_lds_dwordx4 %1, off\n\ts_mov_b32 m0, %0" : "=&s"(keep) : "v"(gsrc), "s"(d) : "memory"); }
template <int NKC, int NVB>
__device__ __forceinline__ void stage_tile(LAS unsigned char* buf, const bf16_t* ktile, int kpitch, const bf16_t* vtile, int vpitch, int wid, int lane) {
    constexpr int NP = NKC + 4 * NVB;
    const unsigned kl = (unsigned)lane * (unsigned)kpitch * 2u;
    const unsigned vl = ((unsigned)(lane >> 2) * (unsigned)vpitch + (unsigned)(lane & 3) * 8u) * 2u;
#pragma unroll
    for (int i = 0; i < (NP + 7) / 8; ++i) {
        const int pc = i * 8 + wid;
        if (pc < NP) {
            const char* ub; unsigned vo;
            if (pc < NKC) { ub = (const char*)ktile + pc * 16; vo = kl; }
            else { const int pv = pc - NKC, db = pv >> 2, kg = pv & 3; ub = (const char*)vtile + ((size_t)kg * 16 * vpitch + db * 32) * 2; vo = vl; }
            __builtin_amdgcn_global_load_lds((const unsigned*)(ub + vo), (LAS unsigned*)(buf + pc * 1024), 16, 0, 0);
        }
    }
}
__device__ __forceinline__ void wait_vm_bar(int n_pieces) {
    switch (n_pieces) {
        case 0: asm volatile("s_waitcnt vmcnt(0)" ::: "memory"); break;
        case 2: asm volatile("s_waitcnt vmcnt(2)" ::: "memory"); break;
        case 3: asm volatile("s_waitcnt vmcnt(3)" ::: "memory"); break;
        case 4: asm volatile("s_waitcnt vmcnt(4)" ::: "memory"); break;
        case 6: asm volatile("s_waitcnt vmcnt(6)" ::: "memory"); break;
        case 8: asm volatile("s_waitcnt vmcnt(8)" ::: "memory"); break;
        case 9: asm volatile("s_waitcnt vmcnt(9)" ::: "memory"); break;
        case 12: asm volatile("s_waitcnt vmcnt(12)" ::: "memory"); break;
        default: asm volatile("s_waitcnt vmcnt(0)" ::: "memory"); break;
    }
    asm volatile("s_waitcnt lgkmcnt(0)" ::: "memory"); __builtin_amdgcn_s_barrier(); asm volatile("" ::: "memory");
}
template <int NST, int PPW, class StageFn, class ComputeFn>
__device__ __forceinline__ void tile_stream(int tb, int te, StageFn stage, ComputeFn compute) {
#pragma unroll
    for (int s2 = 0; s2 < NST - 1; ++s2) if (tb + s2 <= te) stage(tb + s2, s2);
    int slot = 0;
    for (int t = tb; t <= te; ++t) {
        int ahead = te - t; ahead = ahead > NST - 2 ? NST - 2 : ahead;
        wait_vm_bar(ahead * PPW);
        int ns = slot + NST - 1; ns = ns >= NST ? ns - NST : ns;
        if (t + NST - 1 <= te) stage(t + NST - 1, ns);
        compute(t, slot);
        slot = (slot + 1 == NST) ? 0 : slot + 1;
    }
}

__device__ __forceinline__ float max3f(float a, float b, float c) { float r; asm("v_max3_f32 %0, %1, %2, %3" : "=v"(r) : "v"(a), "v"(b), "v"(c)); return r; }
__device__ __forceinline__ float max2f(float a, float b) { float r; asm("v_max_f32_e32 %0, %1, %2" : "=v"(r) : "v"(a), "v"(b)); return r; }
template <int OFF> __device__ __forceinline__ bf16x8 lds_r128(unsigned addr) { bf16x8 v; asm volatile("ds_read_b128 %0, %1 offset:%2" : "=v"(v) : "v"(addr), "i"(OFF)); return v; }
template <int OFF> __device__ __forceinline__ s16x4 lds_rtr(unsigned addr) { s16x4 v; asm volatile("ds_read_b64_tr_b16 %0, %1 offset:%2" : "=v"(v) : "v"(addr), "i"(OFF)); return v; }
#define LGKM_WAIT(n) do { asm volatile("s_waitcnt lgkmcnt(" #n ")" ::: "memory"); __builtin_amdgcn_sched_barrier(0); } while (0)
struct VFrag { s16x4 lo[4], hi[4]; };
__device__ __forceinline__ void vfrag_read(VFrag& f, unsigned va) {
    f.lo[0] = lds_rtr<0>(va); f.hi[0] = lds_rtr<512>(va); f.lo[1] = lds_rtr<1024>(va); f.hi[1] = lds_rtr<1536>(va);
    f.lo[2] = lds_rtr<2048>(va); f.hi[2] = lds_rtr<2560>(va); f.lo[3] = lds_rtr<3072>(va); f.hi[3] = lds_rtr<3584>(va);
}
#define VFR(f, k) (bf16x8){f.lo[k][0], f.lo[k][1], f.lo[k][2], f.lo[k][3], f.hi[k][0], f.hi[k][1], f.hi[k][2], f.hi[k][3]}
template <int DQ, int NDB, bool MASKED, class Post>
__device__ __forceinline__ void attn_qk_sm(const LAS unsigned char* kb, const bf16x8 (&qr)[DQ / 16], f32x16 p0, f32x16 p1,
                                           f32x16 (&o)[NDB], float& m, float& l, bool first, float& seen, int lane, Post post, bf16x8 (&pf)[4]) {
    constexpr float THR = 8.0f;
    const int r32 = lane & 31, hi = lane >> 5;
    const unsigned kaddr = (unsigned)(unsigned long)(kb + hi * 1024 + r32 * 16);
#pragma unroll
    for (int g = 0; g < DQ / 64; ++g) {
        const unsigned ka = kaddr + g * 8192;
        {   const bf16x8 k0 = lds_r128<0>(ka), k1 = lds_r128<512>(ka), k2 = lds_r128<2048>(ka), k3 = lds_r128<2560>(ka);
            LGKM_WAIT(0);
            p0 = MFMA32(k0, qr[4 * g], p0); p1 = MFMA32(k1, qr[4 * g], p1); p0 = MFMA32(k2, qr[4 * g + 1], p0); p1 = MFMA32(k3, qr[4 * g + 1], p1); }
        {   const bf16x8 k4 = lds_r128<4096>(ka), k5 = lds_r128<4608>(ka), k6 = lds_r128<6144>(ka), k7 = lds_r128<6656>(ka);
            LGKM_WAIT(0);
            p0 = MFMA32(k4, qr[4 * g + 2], p0); p1 = MFMA32(k5, qr[4 * g + 2], p1); p0 = MFMA32(k6, qr[4 * g + 3], p0); p1 = MFMA32(k7, qr[4 * g + 3], p1); }
    }
    post(p0, p1);
    asm volatile("s_nop 15\n\ts_nop 7" : "+v"(p0), "+v"(p1));
    float ma = max3f(p0[0], p0[1], p1[0]), mb = max3f(p0[2], p0[3], p1[1]); ma = max3f(ma, p1[2], p1[3]);
#pragma unroll
    for (int r = 4; r < 16; r += 4) { ma = max3f(ma, p0[r], p0[r + 1]); mb = max3f(mb, p0[r + 2], p0[r + 3]); ma = max3f(ma, p1[r], p1[r + 1]); mb = max3f(mb, p1[r + 2], p1[r + 3]); }
    float rm = max2f(ma, mb); rm = max2f(rm, __shfl_xor(rm, 32));
    float delta, alpha_on;
    if (MASKED) { const bool real = rm > -1e29f; delta = real ? ((seen == 0.f || rm > THR) ? rm : 0.f) : 0.f; alpha_on = seen; if (real) seen = 1.f; }
    else { delta = (first || rm > THR) ? rm : 0.f; alpha_on = first ? 0.f : 1.f; }
    if (__any(delta != 0.f)) {
        m += delta;
        const float alpha = (alpha_on != 0.f) ? __builtin_amdgcn_exp2f(-delta) : 1.0f;
#pragma unroll
        for (int r = 0; r < 16; ++r) { p0[r] -= delta; p1[r] -= delta; }
        l *= alpha;
#pragma unroll
        for (int db = 0; db < NDB; ++db) o[db] *= alpha;
    }
    float rs = 0.f;
#pragma unroll
    for (int r = 0; r < 16; ++r) { p0[r] = __builtin_amdgcn_exp2f(p0[r]); p1[r] = __builtin_amdgcn_exp2f(p1[r]); rs += p0[r] + p1[r]; }
    l += rs;
    pf[0] = pack8(p0[0], p0[1], p0[2], p0[3], p0[4], p0[5], p0[6], p0[7]); pf[1] = pack8(p0[8], p0[9], p0[10], p0[11], p0[12], p0[13], p0[14], p0[15]);
    pf[2] = pack8(p1[0], p1[1], p1[2], p1[3], p1[4], p1[5], p1[6], p1[7]); pf[3] = pack8(p1[8], p1[9], p1[10], p1[11], p1[12], p1[13], p1[14], p1[15]);
}
template <int NDB, bool PIPE>
__device__ __forceinline__ void attn_pv(const LAS unsigned char* vb, const bf16x8 (&pf)[4], f32x16 (&o)[NDB], int lane) {
    const int hi = lane >> 5;
    const unsigned vaddr = (unsigned)(unsigned long)(vb + (4 * hi + ((lane & 15) >> 2)) * 64 + ((lane >> 4) & 1) * 32 + (lane & 3) * 8);
    VFrag fa, fb;
    if (PIPE) {
        vfrag_read(fa, vaddr);
#pragma unroll
        for (int db = 0; db < NDB; ++db) {
            VFrag& cur = (db & 1) ? fb : fa; VFrag& nxt = (db & 1) ? fa : fb;
            if (db + 1 < NDB) { vfrag_read(nxt, vaddr + (db + 1) * 4096); LGKM_WAIT(8); } else { LGKM_WAIT(0); }
            o[db] = MFMA32(VFR(cur, 0), pf[0], o[db]); o[db] = MFMA32(VFR(cur, 1), pf[1], o[db]); o[db] = MFMA32(VFR(cur, 2), pf[2], o[db]); o[db] = MFMA32(VFR(cur, 3), pf[3], o[db]);
        }
    } else {
#pragma unroll
        for (int db = 0; db < NDB; ++db) {
            vfrag_read(fa, vaddr + db * 4096); LGKM_WAIT(0);
            o[db] = MFMA32(VFR(fa, 0), pf[0], o[db]); o[db] = MFMA32(VFR(fa, 1), pf[1], o[db]); o[db] = MFMA32(VFR(fa, 2), pf[2], o[db]); o[db] = MFMA32(VFR(fa, 3), pf[3], o[db]);
        }
    }
}
template <int DQ, int NDB, bool MASKED, class Post>
__device__ __forceinline__ void attn_step(const LAS unsigned char* kb, const LAS unsigned char* vb, const bf16x8 (&qr)[DQ / 16], f32x16 p0, f32x16 p1,
                                          f32x16 (&o)[NDB], float& m, float& l, bool first, float& seen, int lane, Post post) {
    bf16x8 pf[4];
    attn_qk_sm<DQ, NDB, MASKED>(kb, qr, p0, p1, o, m, l, first, seen, lane, post, pf);
    attn_pv<NDB, (DQ == 64)>(vb, pf, o, lane);
}
template <int NST, int PPW, class StageFn, class QkFn, class PvFn>
__device__ __forceinline__ void tile_stream_stag(int tb, int te, bool trailing, StageFn stage, QkFn qk, PvFn pv) {
#pragma unroll
    for (int s2 = 0; s2 < NST - 2; ++s2) if (tb + s2 <= te) stage(tb + s2, s2);
    int slot = 0, pslot = 0;
    for (int t = tb; t <= te; ++t) {
        int ahead = te - t; ahead = ahead > NST - 3 ? NST - 3 : ahead;
        wait_vm_bar(ahead * PPW);
        int ns = slot + NST - 2; ns = ns >= NST ? ns - NST : ns;
        if (t + NST - 2 <= te) stage(t + NST - 2, ns);
        if (trailing) { if (t > tb) pv(t - 1, pslot); qk(t, slot); }
        else { qk(t, slot); pv(t, slot); }
        pslot = slot; slot = (slot + 1 == NST) ? 0 : slot + 1;
    }
    if (trailing && te >= tb) pv(te, pslot);
}
__device__ __forceinline__ void store_o16(bf16_t* dst, const f32x16& o, float sc, int hi) {
#pragma unroll
    for (int g = 0; g < 4; ++g) { u32x2 w; w.x = pk2(o[4 * g] * sc, o[4 * g + 1] * sc); w.y = pk2(o[4 * g + 2] * sc, o[4 * g + 3] * sc); *(u32x2*)(dst + 8 * g + 4 * hi) = w; }
}


__device__ __forceinline__ int pop_unit(CParams& p, int ctr, LAS unsigned char* lds, int tid) {
    wg_sync();
    if (tid == 0) *(LAS int*)(lds + LDS_MISC + 2048) = atomicAdd((int*)(WSX + CT_QCTR) + ctr * 16, 1);
    wg_sync();
    return *(const LAS int*)(lds + LDS_MISC + 2048);
}
__device__ __forceinline__ void ph_norms(CParams& p, int layer, LAS unsigned char* lds, int WIDS) {
    const int tid = TIDX, lane = tid & 63, w = tid >> 6;
    const bf16_t* proj = (const bf16_t*)(WSX + WS_BIG);
    float mx[4] = {0.f, 0.f, 0.f, 0.f};
    for (int tok = BIDX * 8 + w; tok < T; tok += GDIM * 8) {
        const bf16_t* row = proj + (size_t)tok * NINP;
#pragma unroll
        for (int k = 0; k < 2; ++k) {
            const int off = (k == 0) ? OFF_QA : OFF_KA; const int width = 512;
            float ss = 0.f;
            if (lane * 8 < width) { const u32x4 v = *(const u32x4*)(row + off + lane * 8);
                const float e0 = __uint_as_float(v.x << 16), e1 = __uint_as_float(v.x & 0xffff0000u), e2 = __uint_as_float(v.y << 16), e3 = __uint_as_float(v.y & 0xffff0000u);
                const float e4 = __uint_as_float(v.z << 16), e5 = __uint_as_float(v.z & 0xffff0000u), e6 = __uint_as_float(v.w << 16), e7 = __uint_as_float(v.w & 0xffff0000u);
                ss = (e0 * e0 + e1 * e1) + (e2 * e2 + e3 * e3) + (e4 * e4 + e5 * e5) + (e6 * e6 + e7 * e7); }
            ss += __shfl_xor(ss, 1); ss += __shfl_xor(ss, 2); ss += __shfl_xor(ss, 4);
            mx[k] = fmaxf(mx[k], ss);
        }
    }
    LAS float* red = (LAS float*)(lds + LDS_MISC + 4096);
    __syncthreads();
#pragma unroll
    for (int k = 0; k < 4; ++k) { float v = mx[k];
#pragma unroll
        for (int o = 32; o > 0; o >>= 1) v = fmaxf(v, __shfl_xor(v, o));
        if (lane == 0) red[w * 4 + k] = v; }
    __syncthreads();
    if (tid < 4) { float v = red[tid]; for (int ww = 1; ww < 8; ++ww) v = fmaxf(v, red[ww * 4 + tid]); ((float*)(WSX + CT_NORM))[(layer * 512 + BIDX) * 4 + tid] = v; }
    __syncthreads();
}
__device__ __forceinline__ float norm_max(CParams& p, int layer, int k, int lane) {
    const float* arr = (const float*)(WSX + CT_NORM) + (size_t)layer * 512 * 4; float v = 0.f; const int G = GDIM;
    for (int bb = lane; bb < G; bb += 64) v = fmaxf(v, arr[bb * 4 + k]);
#pragma unroll
    for (int o = 32; o > 0; o >>= 1) v = fmaxf(v, __shfl_xor(v, o));
    return v;
}

__device__ __forceinline__ void cross_unit(CParams& p, LAS unsigned char* lds, int WIDS, int b, int h, int qb) {
    const int tid = TIDX, lane = tid & 63, wid = __builtin_amdgcn_readfirstlane(tid >> 6), r32 = lane & 31, hi = lane >> 5;
    const int qg = wid & 3, dvh = wid >> 2;
    const bf16_t* Qx = (const bf16_t*)(WSX + WS_BIG); const bf16_t* KV = (const bf16_t*)(WSX + WS_KV); bf16_t* O = (bf16_t*)(WSX + WS_B1);
    constexpr int TILE = 65536; const float c2 = 0.0625f * LOG2E;
    {
        const int tok = b * S + qb * 128 + qg * 32 + r32;
        bf16x8 qr[16];
#pragma unroll
        for (int d0 = 0; d0 < 16; ++d0) qr[d0] = scale8(*(const u32x4*)(Qx + (size_t)tok * D + h * 256 + d0 * 16 + hi * 8), c2);
        f32x16 o[4];
#pragma unroll
        for (int db = 0; db < 4; ++db)
#pragma unroll
            for (int r = 0; r < 16; ++r) o[db][r] = 0.f;
        float m = 0.f, l = 0.f, seen = 0.f;
        const bf16_t* kt0 = KV + (size_t)(b * NMEM) * 2048 + h * 256; const bf16_t* vt0 = kt0 + 1024;
        wg_sync();
        stage_tile<32, 8>(lds, kt0, 2048, vt0, 2048, wid, lane);
        for (int t = 0; t < 4; ++t) {
            wg_sync();
            if (t + 1 < 4) stage_tile<32, 8>(lds + ((t + 1) & 1) * TILE, kt0 + (size_t)(t + 1) * 64 * 2048, 2048, vt0 + (size_t)(t + 1) * 64 * 2048, 2048, wid, lane);
            const LAS unsigned char* buf = lds + (t & 1) * TILE;
            f32x16 z;
#pragma unroll
            for (int r = 0; r < 16; ++r) z[r] = -m;
            attn_step<256, 4, false>(buf, buf + 32768 + dvh * 16384, qr, z, z, o, m, l, t == 0, seen, lane, [](f32x16&, f32x16&) {});
        }
        l += __shfl_xor(l, 32); const float inv = 1.0f / l;
        { const int tid2 = TIDX, lane2 = tid2 & 63, wid2 = tid2 >> 6;
          const int tok2 = b * S + qb * 128 + (wid2 & 3) * 32 + (lane2 & 31);
          bf16_t* orow = O + (size_t)tok2 * D + h * 256 + (wid2 >> 2) * 128;
#pragma unroll
          for (int db = 0; db < 4; ++db) store_o16(orow + db * 32, o[db], inv, lane2 >> 5); }
    }
}

__device__ __forceinline__ void ph_band(CParams& p, int layer, LAS unsigned char* lds, int WIDS) {
    const int tid = TIDX, lane = tid & 63, wid = __builtin_amdgcn_readfirstlane(tid >> 6), r32 = lane & 31, hi = lane >> 5;
    const bf16_t* proj = (const bf16_t*)(WSX + WS_BIG); bf16_t* Y = (bf16_t*)(WSX + WS_B1);
    constexpr int TILE = 16384; const float c2 = 0.125f * LOG2E;
    LAS float* tbl = (LAS float*)(lds + 4 * TILE);
    for (int u = BIDX; u < NB * 4 * 16; u += GDIM) {
        const int qb = u & 15, h = (u >> 4) & 3, b = u >> 6;
        const int cw = 4 * qb + (wid >> 1), tq = 64 * cw + 32 * (wid & 1) + r32, tok = b * S + tq;
        bf16x8 qr[4];
#pragma unroll
        for (int d0 = 0; d0 < 4; ++d0) qr[d0] = scale8(*(const u32x4*)(proj + (size_t)tok * NINP + OFF_QB + h * 64 + d0 * 16 + hi * 8), c2);
        f32x16 o[2];
#pragma unroll
        for (int db = 0; db < 2; ++db)
#pragma unroll
            for (int r = 0; r < 16; ++r) o[db][r] = 0.f;
        float m = 0.f, l = 0.f, seen = 0.f;
        const int t0 = 4 * qb - 8 < 0 ? 0 : 4 * qb - 8, t1 = 4 * qb + 3;
        const bf16_t* kb0 = proj + (size_t)(b * S) * NINP + OFF_KB + h * 64; const bf16_t* vb0 = proj + (size_t)(b * S) * NINP + OFF_VB + h * 64;
        wg_sync();
        if (tid < 257) tbl[tid] = asg(p.relb)[(layer * 4 + h) * 257 + tid] * LOG2E;
        tile_stream<4, 2>(t0, t1,
            [&](int t, int slot) { stage_tile<8, 2>(lds + slot * TILE, kb0 + (size_t)t * 64 * NINP, NINP, vb0 + (size_t)t * 64 * NINP, NINP, wid, lane); },
            [&](int t, int slot) {
                if (t >= cw - 8 && t <= cw) {
                    const LAS unsigned char* buf = lds + slot * TILE;
                    f32x16 p0, p1;
                    if (cw - t >= 3) { const float cb = tbl[256] - m;
#pragma unroll
                        for (int r = 0; r < 16; ++r) { p0[r] = cb; p1[r] = cb; } }
                    else { const int rel0 = tq - (64 * t + 4 * hi);
#pragma unroll
                        for (int r = 0; r < 16; ++r) { const int c = (r & 3) + 8 * (r >> 2); int ra = rel0 - c, rb = rel0 - c - 32;
                            ra = ra < -128 ? -128 : (ra > 128 ? 128 : ra); rb = rb < -128 ? -128 : (rb > 128 ? 128 : rb);
                            p0[r] = tbl[ra + 128] - m; p1[r] = tbl[rb + 128] - m; } }
                    attn_step<64, 2, false>(buf, buf + 8192, qr, p0, p1, o, m, l, t == (cw - 8 < 0 ? 0 : cw - 8), seen, lane, [](f32x16&, f32x16&) {});
                } });
        l += __shfl_xor(l, 32); const float inv = 1.0f / l;
        bf16_t* orow = Y + (size_t)tok * D + 512 + h * 64;
#pragma unroll
        for (int db = 0; db < 2; ++db) store_o16(orow + db * 32, o[db], inv, hi);
    }
    wg_sync();
}

__device__ __forceinline__ void ph_diff(CParams& p, int layer, LAS unsigned char* lds, int WIDS) {
    const int tid0 = TIDX;
    const bf16_t* proj = (const bf16_t*)(WSX + WS_BIG); bf16_t* Y = (bf16_t*)(WSX + WS_B1);
    const float* lamp = (const float*)(WSX + CT_LAM); const float lam = lamp[layer * 2], lam_init = lamp[layer * 2 + 1];
    const float* gain = asg(p.dgain) + layer * 128;
    constexpr int TILE = 32768; const float c2 = 0.125f * LOG2E;
    const int G = GDIM, bid = BIDX; const int vcu = (G % 8 == 0) ? (bid % 8) * (G / 8) + bid / 8 : bid;
    LAS float* gl = (LAS float*)(lds + LDS_MISC + 1024);
    if (tid0 < 128) gl[tid0] = gain[tid0] * (1.0f - lam_init);
    const int nq = (G % 8 == 0) ? 8 : 1, qid = bid % nq, ctr = (layer * 3 + 0) * 8 + qid;
    const float Bq = c2 * sqrtf(norm_max(p, layer, 0, tid0 & 63) * norm_max(p, layer, 1, tid0 & 63)) * 1.01f;
    for (;;) {
        const int tid = TIDX, lane = tid & 63, wid = __builtin_amdgcn_readfirstlane(tid >> 6), r32 = lane & 31, hi = lane >> 5;
        const int qg = wid & 3, map = wid >> 2;
        const int idx = pop_unit(p, ctr, lds, tid);
        if (idx >= (NB * 4 * 32) / nq) break;
        const int u = (qid + nq * (idx >> 7)) * 128 + (idx & 3) * 32 + (31 - ((idx & 127) >> 2));
        const int qb = u & 31, h = (u >> 5) & 3, b = u >> 7;
        const int tq = 128 * qb + 32 * qg + r32, tok = b * S + tq, cq = 2 * qb + (qg >> 1);
        const float slope2 = exp2f(-(float)(2 * h + 1)) * LOG2E;
        bf16x8 qr[4];
#pragma unroll
        for (int d0 = 0; d0 < 4; ++d0) qr[d0] = scale8(*(const u32x4*)(proj + (size_t)tok * NINP + OFF_QA + h * 128 + map * 64 + d0 * 16 + hi * 8), c2);
        f32x16 o[4];
#pragma unroll
        for (int db = 0; db < 4; ++db)
#pragma unroll
            for (int r = 0; r < 16; ++r) o[db][r] = 0.f;
        float m = 0.f, l = 0.f, seen = 0.f;
        const int t1 = 2 * qb + 1;
        int ts = (int)ceilf(((float)(128 * qb - 63) - (160.0f + 2.0f * Bq) / slope2) * (1.0f / 64.0f)); ts = ts < 0 ? 0 : ts; ts = __builtin_amdgcn_readfirstlane(ts);
        const bf16_t* kb0 = proj + (size_t)(b * S) * NINP + OFF_KA + h * 128; const bf16_t* vb0 = proj + (size_t)(b * S) * NINP + OFF_VA + h * 128;
        wg_sync();
        tile_stream<4, 4>(ts, t1,
            [&](int t, int slot) { stage_tile<16, 4>(lds + slot * TILE, kb0 + (size_t)t * 64 * NINP, NINP, vb0 + (size_t)t * 64 * NINP, NINP, wid, lane); },
            [&](int t, int slot) {
                if (t <= cq) {
                    const LAS unsigned char* buf = lds + slot * TILE;
                    f32x16 p0, p1; const float dq = (float)(64 * t + 4 * hi - tq);
                    if (t == cq) {
#pragma unroll
                        for (int r = 0; r < 16; ++r) { const float c = (float)((r & 3) + 8 * (r >> 2)); p0[r] = fmaf(-slope2, fabsf(dq + c), -m); p1[r] = fmaf(-slope2, fabsf(dq + c + 32.0f), -m); }
                    } else { const float sb = slope2 * dq - m;
#pragma unroll
                        for (int r = 0; r < 16; ++r) { const float c = (float)((r & 3) + 8 * (r >> 2)); p0[r] = fmaf(slope2, c, sb); p1[r] = fmaf(slope2, c + 32.0f, sb); }
                    }
                    attn_step<64, 4, false>(buf + map * 8192, buf + 16384, qr, p0, p1, o, m, l, t == ts, seen, lane, [](f32x16&, f32x16&) {});
                } });
        l += __shfl_xor(l, 32); const float inv = 1.0f / l;
        wg_sync();
        LAS float* xch = (LAS float*)lds + qg * 4096 + r32;
        if (map == 1) {
#pragma unroll
            for (int db = 0; db < 4; ++db)
#pragma unroll
                for (int r = 0; r < 16; ++r) xch[(db * 32 + (r & 3) + 8 * (r >> 2) + 4 * hi) * 32] = o[db][r] * inv;
        }
        wg_sync();
        if (map == 0) {
            float ss = 0.f;
#pragma unroll
            for (int db = 0; db < 4; ++db)
#pragma unroll
                for (int r = 0; r < 16; ++r) { const float y = o[db][r] * inv - lam * xch[(db * 32 + (r & 3) + 8 * (r >> 2) + 4 * hi) * 32]; o[db][r] = y; ss += y * y; }
            ss += __shfl_xor(ss, 32);
            const float rn = rsqrtf(ss * (1.0f / 128.0f) + RMS_EPS);
            bf16_t* orow = Y + (size_t)tok * D + h * 128;
#pragma unroll
            for (int db = 0; db < 4; ++db)
#pragma unroll
                for (int g = 0; g < 4; ++g) { const int d = db * 32 + 8 * g + 4 * hi; const f32x4 gn = *(const LAS f32x4*)(gl + d);
                    u32x2 w; w.x = pk2(o[db][4 * g] * rn * gn[0], o[db][4 * g + 1] * rn * gn[1]); w.y = pk2(o[db][4 * g + 2] * rn * gn[2], o[db][4 * g + 3] * rn * gn[3]);
                    *(u32x2*)(orow + d) = w; }
        }
    }
    wg_sync();
}

__device__ __forceinline__ size_t isc_tri(int c) { return (size_t)4096 * (size_t)(c * (c + 1) / 2); }
#define ISC_PTR(b_) ((b_) < ISC_IN_WBIG ? (float*)(WSX + WS_WBIG) + (size_t)(b_) * ISC_BATCH : (float*)asg(p.out) + (size_t)((b_) - ISC_IN_WBIG) * ISC_BATCH)
#define MASK_PTR ((unsigned long long*)((unsigned char*)asg(p.out) + OUT_MASK))
__device__ __forceinline__ void wave_lds_sync() { asm volatile("s_waitcnt lgkmcnt(0)" ::: "memory"); }

__device__ __forceinline__ unsigned fkey32(float f) { const unsigned u = __float_as_uint(f); return (u & 0x80000000u) ? ~u : (u | 0x80000000u); }
__device__ __forceinline__ void d2_chunk_pair(CParams& p, int b, int cp, LAS unsigned char* lds, int WIDS) {
    const int tid = TIDX; int lane = tid & 63; const int wid = __builtin_amdgcn_readfirstlane(tid >> 6);
    unsigned long long* mask = MASK_PTR;
    LAS unsigned* hist = (LAS unsigned*)(lds + wid * 9216);
    LAS unsigned* list = hist + 1024;
    LAS unsigned* rowb = list + 1024;
    LAS unsigned* lcnt = rowb + 128;
    const float NINF = -INFINITY;
    const int lane0 = lane;
    f32x4 v[16];
#define D2_ROW_T(i2) (64 * (((i2) & 1) ? 63 - cp : cp) + wid + 8 * ((i2) >> 1))
#define D2_LOAD_ROW(tx) do { const int bl_ = b, t_ = (tx), c_ = t_ >> 6, n_ = 64 * (c_ + 1); \
        const float* row_ = ISC_PTR(bl_) + isc_tri(c_) + (size_t)(t_ & 63) * (size_t)n_; \
        _Pragma("unroll") for (int i = 0; i < 16; ++i) { if (256 * i + 4 * lane < n_) v[i] = *(const f32x4*)(row_ + 256 * i + 4 * lane); else v[i] = (f32x4){NINF, NINF, NINF, NINF}; } } while (0)
    D2_LOAD_ROW(D2_ROW_T(0));
    for (int i2 = 0; i2 < 16; ++i2) {
        int lane = lane0; asm volatile("" : "+v"(lane));
        const int t = D2_ROW_T(i2), c = t >> 6, n = 64 * (c + 1);
        rowb[lane] = 0u; rowb[lane + 64] = 0u; if (lane == 0) lcnt[0] = 0u;
        unsigned long long selbits = 0ull; bool rank_list = false; unsigned need_r = 0, cstar_r = 0;
        if (n <= 256) { selbits = (4 * lane < n) ? 0xFull : 0ull; }
        else {
            float lo = INFINITY, hi = NINF;
#pragma unroll
            for (int i = 0; i < 16; ++i) if (256 * i + 4 * lane < n) {
#pragma unroll
                for (int q = 0; q < 4; ++q) { lo = fminf(lo, v[i][q]); hi = fmaxf(hi, v[i][q]); } }
#pragma unroll
            for (int o = 32; o > 0; o >>= 1) { lo = fminf(lo, __shfl_xor(lo, o)); hi = fmaxf(hi, __shfl_xor(hi, o)); }
            const float scale = (hi > lo) ? 1024.0f / (hi - lo) : 0.f;
#pragma unroll
            for (int q = 0; q < 16; ++q) hist[q * 64 + lane] = 0u;
            wave_lds_sync();
#define BUCKET(x) min(1023, (int)(((x) - lo) * scale))
#pragma unroll
            for (int i = 0; i < 16; ++i) if (256 * i + 4 * lane < n) {
#pragma unroll
                for (int q = 0; q < 4; ++q) (void)__hip_atomic_fetch_add(hist + BUCKET(v[i][q]), 1u, __ATOMIC_RELAXED, __HIP_MEMORY_SCOPE_WORKGROUP); }
            wave_lds_sync();
            unsigned hb[16]; unsigned ssum = 0;
#pragma unroll
            for (int q = 0; q < 4; ++q) { const u32x4 x = *(const LAS u32x4*)(hist + 16 * lane + 4 * q); hb[4 * q] = x.x; hb[4 * q + 1] = x.y; hb[4 * q + 2] = x.z; hb[4 * q + 3] = x.w; ssum += x.x + x.y + x.z + x.w; }
            unsigned incl = ssum;
#pragma unroll
            for (int o = 1; o < 64; o <<= 1) { const unsigned tt = __shfl_down(incl, o); if (lane + o < 64) incl += tt; }
            const unsigned long long bal = __ballot(incl >= 256u);
            const int L = 63 - __clzll(bal);
            unsigned cum = incl - ssum, cab = 0, cst = 0; int bks = 0; bool found = false;
#pragma unroll
            for (int bk = 15; bk >= 0; --bk) { if (!found && cum + hb[bk] >= 256u) { found = true; bks = bk; cab = cum; cst = hb[bk]; } if (!found) cum += hb[bk]; }
            const int bstar = __shfl(16 * lane + bks, L); const unsigned cnt_above = __shfl(cab, L), cstar = __shfl(cst, L);
            const unsigned need = 256u - cnt_above;
            const bool listmode = (need != cstar);
#pragma unroll
            for (int i = 0; i < 16; ++i) if (256 * i + 4 * lane < n) {
#pragma unroll
                for (int q = 0; q < 4; ++q) { const int bk = BUCKET(v[i][q]);
                    if (bk > bstar || (bk == bstar && !listmode)) selbits |= 1ull << (4 * i + q);
                    else if (bk == bstar) { const unsigned slot = __hip_atomic_fetch_add(lcnt, 1u, __ATOMIC_RELAXED, __HIP_MEMORY_SCOPE_WORKGROUP);
                        if (slot < 512u) { list[2 * slot] = fkey32(v[i][q]); list[2 * slot + 1] = (unsigned)(256 * i + 4 * lane + q); } } } }
            if (listmode) {
                if (cstar <= 512u) { rank_list = true; need_r = need; cstar_r = cstar; }
                else {
                    unsigned long long Tk = 0ull;
                    for (int bit = 43; bit >= 0; --bit) { const unsigned long long trial = Tk | (1ull << bit); unsigned cc = 0;
#pragma unroll
                        for (int i = 0; i < 16; ++i) if (256 * i + 4 * lane < n) {
#pragma unroll
                            for (int q = 0; q < 4; ++q) { const unsigned long long ck = ((unsigned long long)fkey32(v[i][q]) << 12) | (unsigned long long)(4095 - (256 * i + 4 * lane + q));
                                cc += (BUCKET(v[i][q]) == bstar && ck >= trial) ? 1u : 0u; } }
#pragma unroll
                        for (int o = 32; o > 0; o >>= 1) cc += __shfl_xor(cc, o);
                        if (cc >= need) Tk = trial; }
#pragma unroll
                    for (int i = 0; i < 16; ++i) if (256 * i + 4 * lane < n) {
#pragma unroll
                        for (int q = 0; q < 4; ++q) { const unsigned long long ck = ((unsigned long long)fkey32(v[i][q]) << 12) | (unsigned long long)(4095 - (256 * i + 4 * lane + q));
                            if (BUCKET(v[i][q]) == bstar && ck >= Tk) selbits |= 1ull << (4 * i + q); } }
                }
            }
#undef BUCKET
        }
        if (i2 + 1 < 16) D2_LOAD_ROW(D2_ROW_T(i2 + 1));
        if (rank_list) {
            wave_lds_sync();
            for (unsigned e = lane; e < cstar_r; e += 64) { const unsigned mk = list[2 * e], mi = list[2 * e + 1]; unsigned rank = 0;
                for (unsigned j2 = 0; j2 < cstar_r; ++j2) { const unsigned k2 = list[2 * j2], i2 = list[2 * j2 + 1]; rank += (k2 > mk || (k2 == mk && i2 < mi)) ? 1u : 0u; }
                if (rank < need_r) (void)__hip_atomic_fetch_or(rowb + (mi >> 5), 1u << (mi & 31), __ATOMIC_RELAXED, __HIP_MEMORY_SCOPE_WORKGROUP); }
        }
#pragma unroll
        for (int i = 0; i < 16; ++i) { const unsigned nib = (unsigned)(selbits >> (4 * i)) & 0xFu;
            if (nib) (void)__hip_atomic_fetch_or(rowb + 8 * i + (lane >> 3), nib << (4 * (lane & 7)), __ATOMIC_RELAXED, __HIP_MEMORY_SCOPE_WORKGROUP); }
        wave_lds_sync();
        if (lane <= c) mask[((size_t)b * 64 + lane) * S + t] = (unsigned long long)rowb[2 * lane] | ((unsigned long long)rowb[2 * lane + 1] << 32);
        wave_lds_sync();
    }
#undef D2_LOAD_ROW
#undef D2_ROW_T
    wg_sync();
}

__device__ __forceinline__ void ph_d1(CParams& p, int round, LAS unsigned char* lds, int WIDS) {
    const int tid = TIDX, lane = tid & 63, wid = __builtin_amdgcn_readfirstlane(tid >> 6), r32 = lane & 31, hi = lane >> 5;
    const int qh = wid & 1, j = wid >> 1;
    const bf16_t* proj = (const bf16_t*)(WSX + WS_BIG);
    const int G = GDIM, bid = BIDX; const int vcu = (G % 8 == 0) ? (bid % 8) * (G / 8) + bid / 8 : bid;
    for (int s = vcu; s < 256; s += G) {
        const int b = s >> 5, cp = s & 31;
        for (int k2 = 0; k2 < 2; ++k2) {
            const int c = k2 == 0 ? cp : 63 - cp;
            wg_sync();
#pragma unroll
            for (int i = 0; i < 8; ++i) { const int pc = i * 8 + wid;
                __builtin_amdgcn_global_load_lds((const unsigned*)(proj + (size_t)(b * S + 64 * c + lane) * NINP + OFF_QI + pc * 8), (LAS unsigned*)(lds + pc * 1024), 16, 0, 0); }
            const int tokq = b * S + 64 * c + qh * 32 + r32;
            float w[8];
            { const u32x4 wv = *(const u32x4*)(proj + (size_t)tokq * NINP + OFF_WI); const float sc = 0.125f * 0.35355339059f;
              w[0] = __uint_as_float(wv.x << 16) * sc; w[1] = __uint_as_float(wv.x & 0xffff0000u) * sc; w[2] = __uint_as_float(wv.y << 16) * sc; w[3] = __uint_as_float(wv.y & 0xffff0000u) * sc;
              w[4] = __uint_as_float(wv.z << 16) * sc; w[5] = __uint_as_float(wv.z & 0xffff0000u) * sc; w[6] = __uint_as_float(wv.w << 16) * sc; w[7] = __uint_as_float(wv.w & 0xffff0000u) * sc; }
            LAS float* wq = (LAS float*)(lds + 65536) + qh * 32 + r32;
            if (hi == 0) {
#pragma unroll
                for (int h = 0; h < 8; ++h) wq[h * 64] = w[h]; }
            wg_sync();
            float* orow = ISC_PTR(b) + isc_tri(c) + (size_t)(qh * 32 + r32) * (size_t)(64 * (c + 1));
            const LAS unsigned char* qp = lds + hi * 1024 + (qh * 32 + r32) * 16;
            for (int t = j; t <= c; t += 4) {
                const bf16_t* kp = proj + (size_t)(b * S + 64 * t + r32) * NINP + OFF_KI + hi * 8;
                bf16x8 ka[2][4];
#pragma unroll
                for (int kh = 0; kh < 2; ++kh)
#pragma unroll
                    for (int d0 = 0; d0 < 4; ++d0) ka[kh][d0] = *(const bf16x8*)(kp + (size_t)kh * 32 * NINP + d0 * 16);
                f32x16 a0, a1;
#pragma unroll
                for (int r = 0; r < 16; ++r) { a0[r] = 0.f; a1[r] = 0.f; }
#define D1_QK(P0, P1, hh) do { _Pragma("unroll") for (int r = 0; r < 16; ++r) { P0[r] = 0.f; P1[r] = 0.f; } \
        _Pragma("unroll") for (int d0 = 0; d0 < 4; ++d0) { const bf16x8 bq = *(const LAS bf16x8*)(qp + ((hh) * 8 + 2 * d0) * 1024); P0 = MFMA32(ka[0][d0], bq, P0); P1 = MFMA32(ka[1][d0], bq, P1); } } while (0)
#define D1_ACC(P0, P1, hh) do { const float wh_ = wq[(hh) * 64]; \
        _Pragma("unroll") for (int r = 0; r < 16; ++r) { a0[r] = fmaf(wh_, __int_as_float(max(__float_as_int(P0[r]), 0)), a0[r]); a1[r] = fmaf(wh_, __int_as_float(max(__float_as_int(P1[r]), 0)), a1[r]); } \
        asm volatile("" : "+v"(a0), "+v"(a1)); } while (0)
                f32x16 pa0, pa1, pb0, pb1;
                D1_QK(pa0, pa1, 0);
#pragma unroll 1
                for (int h = 0; h < 8; h += 2) {
                    D1_QK(pb0, pb1, h + 1);
                    __builtin_amdgcn_sched_barrier(0);
                    D1_ACC(pa0, pa1, h);
                    if (h + 2 < 8) D1_QK(pa0, pa1, h + 2);
                    __builtin_amdgcn_sched_barrier(0);
                    D1_ACC(pb0, pb1, h + 1);
                }
#undef D1_QK
#undef D1_ACC
#pragma unroll
                for (int g = 0; g < 4; ++g) {
                    const f32x4 s0 = {a0[4 * g] + 0.f, a0[4 * g + 1] + 0.f, a0[4 * g + 2] + 0.f, a0[4 * g + 3] + 0.f};
                    const f32x4 s1 = {a1[4 * g] + 0.f, a1[4 * g + 1] + 0.f, a1[4 * g + 2] + 0.f, a1[4 * g + 3] + 0.f};
                    *(f32x4*)(orow + 64 * t + 8 * g + 4 * hi) = s0; *(f32x4*)(orow + 64 * t + 32 + 8 * g + 4 * hi) = s1;
                }
            }
        }
        wg_sync();
        d2_chunk_pair(p, b, cp, lds, WIDS);
    }
    wg_sync();
}

__device__ __forceinline__ void ph_d3(CParams& p, int layer, LAS unsigned char* lds, int WIDS) {
    const int tid = TIDX, lane = tid & 63, wid = __builtin_amdgcn_readfirstlane(tid >> 6), r32 = lane & 31, hi = lane >> 5;
    const int qg = wid;
    const bf16_t* proj = (const bf16_t*)(WSX + WS_BIG); bf16_t* Y = (bf16_t*)(WSX + WS_B1);
    const unsigned long long* mask = MASK_PTR;
    constexpr int TILE = 18432; const float c2 = 0.125f * LOG2E;
    const int G = GDIM, bid = BIDX; const int vcu = (G % 8 == 0) ? (bid % 8) * (G / 8) + bid / 8 : bid;
    const int nq = (G % 8 == 0) ? 8 : 1, qid = bid % nq, ctr = (layer * 3 + 1) * 8 + qid;
    for (;;) {
        const int idx = pop_unit(p, ctr, lds, tid);
        if (idx >= (NB * 4 * 16) / nq) break;
        const int u = (qid + nq * (idx >> 6)) * 64 + (idx & 3) * 16 + (15 - ((idx & 63) >> 2));
        const int qb = u & 15, h = (u >> 4) & 3, b = u >> 6;
        const int tq = 256 * qb + 32 * qg + r32, tok = b * S + tq, cq = 4 * qb + (qg >> 1);
        const float slope2 = exp2f(-(float)(2 * h + 2)) * LOG2E;
        bf16x8 qr[4];
#pragma unroll
        for (int d0 = 0; d0 < 4; ++d0) qr[d0] = scale8(*(const u32x4*)(proj + (size_t)tok * NINP + OFF_QC + h * 64 + d0 * 16 + hi * 8), c2);
        f32x16 o[2];
#pragma unroll
        for (int db = 0; db < 2; ++db)
#pragma unroll
            for (int r = 0; r < 16; ++r) o[db][r] = 0.f;
        float m = 0.f, l = 0.f, seen = 0.f;
        const int t1 = 4 * qb + 3;
        const bf16_t* kb0 = proj + (size_t)(b * S) * NINP + OFF_KC + h * 64; const bf16_t* vb0 = proj + (size_t)(b * S) * NINP + OFF_VC + h * 64;
        const unsigned* mbase = (const unsigned*)(mask + ((size_t)b * 64 * S + 256 * qb)) + wid * 64 + lane;
        wg_sync();
        tile_stream<4, 3>(0, t1,
            [&](int t, int slot) { stage_tile<8, 2>(lds + slot * TILE, kb0 + (size_t)t * 64 * NINP, NINP, vb0 + (size_t)t * 64 * NINP, NINP, wid, lane);
                __builtin_amdgcn_global_load_lds(mbase + (size_t)t * S * 2, (LAS unsigned*)(lds + slot * TILE + 16384 + wid * 256), 4, 0, 0); },
            [&](int t, int slot) {
                if (t <= cq) {
                    const LAS unsigned char* buf = lds + slot * TILE;
                    u32x2 mw; asm volatile("ds_read_b64 %0, %1 offset:16384\n\ts_waitcnt lgkmcnt(0)" : "=v"(mw) : "v"((unsigned)(unsigned long)(buf + (qg * 32 + r32) * 8)));
                    const unsigned wl = mw.x >> (4 * hi), wh = mw.y >> (4 * hi);
                    f32x16 p0, p1; const float dq = (float)(64 * t + 4 * hi - tq);
                    if (t == cq) {
#pragma unroll
                        for (int r = 0; r < 16; ++r) { const float c = (float)((r & 3) + 8 * (r >> 2)); p0[r] = fmaf(-slope2, fabsf(dq + c), -m); p1[r] = fmaf(-slope2, fabsf(dq + c + 32.0f), -m); }
                    } else { const float sb = slope2 * dq - m;
#pragma unroll
                        for (int r = 0; r < 16; ++r) { const float c = (float)((r & 3) + 8 * (r >> 2)); p0[r] = fmaf(slope2, c, sb); p1[r] = fmaf(slope2, c + 32.0f, sb); }
                    }
                    attn_step<64, 2, true>(buf, buf + 8192, qr, p0, p1, o, m, l, false, seen, lane, [wl, wh](f32x16& a, f32x16& bb) {
#pragma unroll
                        for (int r = 0; r < 16; ++r) { const int c = (r & 3) + 8 * (r >> 2);
                            const unsigned s0 = (unsigned)__builtin_amdgcn_sbfe((int)wl, c, 1), s1 = (unsigned)__builtin_amdgcn_sbfe((int)wh, c, 1);
                            a[r] = __uint_as_float((__float_as_uint(a[r]) & s0) | (0xF149F2CAu & ~s0)); bb[r] = __uint_as_float((__float_as_uint(bb[r]) & s1) | (0xF149F2CAu & ~s1)); } });
                } });
        l += __shfl_xor(l, 32); const float inv = 1.0f / l;
        bf16_t* orow = Y + (size_t)tok * D + 768 + h * 64;
#pragma unroll
        for (int db = 0; db < 2; ++db) store_o16(orow + db * 32, o[db], inv, hi);
    }
    wg_sync();
}

constexpr int NPHASES = 26;
__global__ void __launch_bounds__(512, 2) mega(Params p_unused) {
    CParams* const kp0 = (CParams*)__builtin_amdgcn_kernarg_segment_ptr();
#define p (*opqk(kp0))
    extern __shared__ __attribute__((aligned(16))) unsigned char lds_raw[];
    LAS unsigned char* ldsL = (LAS unsigned char*)lds_raw;
    float* ldsf = (float*)lds_raw;
    const int WIDS = __builtin_amdgcn_readfirstlane((int)threadIdx.x >> 6);
    const int tid = TIDX;
    for (int u = tid; u < (LDS_BYTES - LDS_MISC) / 4; u += 512) ((LAS unsigned*)(ldsL + LDS_MISC))[u] = 0u;
    __syncthreads();
    const int lo = p.ph_lo, hi = p.ph_hi; const bool one = (hi - lo) > 1;
    XcdBarrier bar; bar.bar = (unsigned*)(WSX + CT_BAR); bar.x = 0; bar.st = nullptr;
    if (one) bar = xcd_barrier_post((unsigned*)(WSX + CT_BAR), (volatile LAS unsigned*)(ldsL + LDS_MISC), WIDS);
    int ph = 0;
#define RUN (ph >= lo && ph < hi)
#define SEAM do { if (ph >= lo && ph + 1 < hi) xcd_barrier(bar, WIDS); ++ph; } while (0)
#define G GDIM
#define bid BIDX
#define vcu ((G % 8 == 0) ? (bid % 8) * (G / 8) + bid / 8 : bid)
#define B0 ((bf16_t*)(WSX + WS_B0))
#define B1 ((bf16_t*)(WSX + WS_B1))
#define BIG ((bf16_t*)(WSX + WS_BIG))
#define WSM ((bf16_t*)(WSX + WS_WSM))
#define WBIG ((bf16_t*)(WSX + WS_WBIG))

    if (RUN) { ph_prologue(p, WIDS); ph_prep_small(p, 0, ldsf, WIDS); }
    SEAM;
    for (int layer = 0; layer < 2; ++layer) {
        if (RUN) {
            { constexpr int KV_PM0 = (int)((WS_MEMB - WS_B0) / ((size_t)256 * D * 2)), KV_PN0 = (int)(WSM_WKV / ((size_t)256 * D));
              static_assert((WS_MEMB - WS_B0) % ((size_t)256 * D * 2) == 0 && WSM_WKV % ((size_t)256 * D) == 0, "KV tiles must sit on the tile grid of Hb / Win_t");
              pg8::Gemm g{B0, WSM + WSM_WIN, T, NINP, D}; pg8::ProjKvOrder so; so.init(T, NINP, G, bid, KV_PM0, KV_PN0);
              pg8::EpiProjKv E{BIG, NINP, (bf16_t*)(WSX + WS_KV), KV_PM0, KV_PN0};
              pg8::gemm_phase<pg8::EpiProjKv, pg8::ProjKvOrder, true, true>(ldsL, g, so, E, WIDS); }
        }
        SEAM;
        if (RUN) { ph_norms(p, layer, ldsL, WIDS); ph_d1(p, 0, ldsL, WIDS); }
        SEAM;
        if (RUN) { const int sub = p.sub; if (sub == 0 || sub == 1) ph_diff(p, layer, ldsL, WIDS); if (sub == 0 || sub == 2) ph_band(p, layer, ldsL, WIDS); if (sub == 0 || sub == 3) ph_d3(p, layer, ldsL, WIDS); }
        SEAM;
        if (RUN) { pg8::Gemm g{B1, WSM + WSM_WOUT, T, D, D}; pg8::StaticOrder so; so.init(T, D, G, bid); pg8::EpiResid E{B0, (bf16_t*)(WSX + WS_ZB)};
            pg8::gemm_phase<pg8::EpiResid, pg8::StaticOrder, true, true>(ldsL, g, so, E, WIDS); }
        SEAM;
        if (RUN) { if (p.sub != 7) ph_layernorm(p, asg(p.ln1g) + layer * D, asg(p.ln1b) + layer * D, WIDS); ph_prep_big(p, layer, ldsf, WIDS); }
        SEAM;
        if (RUN) {
            pg8::StaticOrder so; so.init(T, D, G, bid);
            { pg8::Gemm g{B0, WSM + WSM_WQ, T, D, D}; pg8::EpiStore E{BIG, D, 0};
              pg8::gemm_phase<pg8::EpiStore, pg8::StaticOrder, true, true>(ldsL, g, so, E, WIDS); }
            pg8::Unit u;
            for (int i = 0; so.next(i, u); ++i) { const int b = u.pm >> 4, qb0 = 2 * (u.pm & 15);
                for (int hq = 0; hq < 2; ++hq) cross_unit(p, ldsL, WIDS, b, u.pn, qb0 + hq); }
            __syncthreads();
        }
        SEAM;
        if (RUN) { pg8::Gemm g{B1, WSM + WSM_WO, T, D, D}; pg8::StaticOrder so; so.init(T, D, G, bid); pg8::EpiResid E{B0, (bf16_t*)(WSX + WS_ZB)};
            pg8::gemm_phase<pg8::EpiResid, pg8::StaticOrder, true, true>(ldsL, g, so, E, WIDS); }
        SEAM;
        if (RUN) { if (layer == 0) ph_layernorm(p, asg(p.ln2g) + layer * D, asg(p.ln2b) + layer * D, WIDS); else ph_ln_router(p, asg(p.ln2g) + layer * D, asg(p.ln2b) + layer * D, ldsL, WIDS); }
        SEAM;
        if (layer == 0) {
            if (RUN) { pg8::Gemm g{B0, WBIG, T, 2 * DFF, D}; pg8::StaticOrder so; so.init(T, 2 * DFF, G, bid); pg8::EpiSwiglu E{BIG, DFF, 0};
                pg8::gemm_phase<pg8::EpiSwiglu, pg8::StaticOrder, true, true>(ldsL, g, so, E, WIDS); }
            SEAM;
            if (RUN) { pg8::Gemm g{BIG, WBIG + WB_W2, T, D, DFF}; pg8::StaticOrder so; so.init(T, D, G, bid); pg8::EpiResid E{B0, (bf16_t*)(WSX + WS_ZB)};
                pg8::gemm_phase<pg8::EpiResid, pg8::StaticOrder, true, true>(ldsL, g, so, E, WIDS); }
            SEAM;
            if (RUN) { ph_layernorm(p, asg(p.ln3g) + layer * D, asg(p.ln3b) + layer * D, WIDS); ph_prep_small(p, 1, ldsf, WIDS); }
            SEAM;
        } else {
            if (RUN) ph_scatter(p, ldsL, WIDS);
            SEAM;
            for (int pass = 0; pass < 2; ++pass) {
                const int* cnt = (const int*)(WSX + CT_CNT); int nt = 0;
                for (int e = 0; e < 8; ++e) nt += (cnt[e] + 255) / 256;
                nt = __builtin_amdgcn_readfirstlane(nt);
                const int pstart = pass * 128; int nvalid = pass == 0 ? (nt < 128 ? nt : 128) : (nt - 128 < 0 ? 0 : nt - 128);
                const int* tile_e = (const int*)(WSX + CT_TILEE) + pstart;
                bf16_t* Xg = (bf16_t*)(WSX + WS_XG) + (size_t)pstart * 256 * D;
                if (RUN) { pg8::Gemm g{Xg, WBIG, PASS_ROWS, 2 * DFFE * NE, D}; pg8::MoeOrder mo{tile_e, nvalid, 2 * DFFE / 256, G, vcu}; pg8::EpiSwiglu E{BIG, DFFE, 2 * DFFE / 256};
                    pg8::gemm_phase<pg8::EpiSwiglu, pg8::MoeOrder, true, true>(ldsL, g, mo, E, WIDS); }
                SEAM;
                if (RUN) { pg8::Gemm g{BIG, WBIG + WB_W2E, PASS_ROWS, D * NE, DFFE}; pg8::MoeOrder mo{tile_e, nvalid, D / 256, G, vcu}; pg8::EpiStore E{Xg, D, D / 256};
                    pg8::gemm_phase<pg8::EpiStore, pg8::MoeOrder, true, true>(ldsL, g, mo, E, WIDS); }
                SEAM;
            }
            if (RUN) ph_combine_ln(p, asg(p.ln3g) + layer * D, asg(p.ln3b) + layer * D, WIDS);
            SEAM;
        }
    }
#undef RUN
#undef SEAM
#undef p
#undef G
#undef bid
#undef vcu
}

extern "C" void kernel_launch(void* const* d_in, const int* in_sizes, int n_in, void* d_out, int out_size, void* d_ws, size_t ws_size, hipStream_t stream) {
    static int grid = 0;
    if (grid == 0) {
        if (ws_size < WS_END || n_in < 27) { fprintf(stderr, "kernel_launch: workspace too small: %zu < %zu\n", ws_size, (size_t)WS_END); grid = -1; return; }
        int dev = 0, cus = 0;
        if (hipGetDevice(&dev) != hipSuccess || hipDeviceGetAttribute(&cus, hipDeviceAttributeMultiprocessorCount, dev) != hipSuccess) { grid = -1; return; }
        if (hipFuncSetAttribute((const void*)mega, hipFuncAttributeMaxDynamicSharedMemorySize, LDS_BYTES) != hipSuccess) { fprintf(stderr, "kernel_launch: hipFuncSetAttribute failed\n"); grid = -1; return; }
        int per_cu = 0; (void)hipOccupancyMaxActiveBlocksPerMultiprocessor(&per_cu, (const void*)mega, 512, LDS_BYTES); (void)hipGetLastError();
        if (per_cu < 1) fprintf(stderr, "kernel_launch: occupancy query says %d\n", per_cu);
        grid = cus;
    }
    if (grid < 0) return;
    (void)hipMemsetAsync((char*)d_ws + WS_CTL, 0, CTL_ZERO_BYTES, stream);
    Params p{};
    const float** pp = (const float**)&p;
    for (int i = 0; i < 27; ++i) pp[i] = (const float*)d_in[i];
    p.out = (float*)d_out; p.ws = (unsigned char*)d_ws;
#if MK_DUP_N > 0
    p.ph_lo = 0; p.ph_hi = MK_DUP_PH + 1; hipLaunchKernelGGL(mega, dim3(grid), dim3(512), LDS_BYTES, stream, p);
    for (int r = 0; r < MK_DUP_N; ++r) { (void)hipMemsetAsync((char*)d_ws + CT_QCTR, 0, 8192, stream); p.ph_lo = MK_DUP_PH; p.ph_hi = MK_DUP_PH + 1; p.sub = MK_DUP_SUB; hipLaunchKernelGGL(mega, dim3(grid), dim3(512), LDS_BYTES, stream, p); }
    p.sub = 0; p.ph_lo = MK_DUP_PH + 1; p.ph_hi = 1 << 20;
    (void)hipMemsetAsync((char*)d_ws + WS_CTL, 0, 16384, stream); (void)hipMemsetAsync((char*)d_ws + CT_QCTR + 4096, 0, 4096, stream);
    hipLaunchKernelGGL(mega, dim3(grid), dim3(512), LDS_BYTES, stream, p);
#elif MK_ONE_LAUNCH
    p.ph_lo = 0; p.ph_hi = 1 << 20;
    hipLaunchKernelGGL(mega, dim3(grid), dim3(512), LDS_BYTES, stream, p);
#else
    for (int k = 0; k < NPHASES; ++k) { p.ph_lo = k; p.ph_hi = k + 1; hipLaunchKernelGGL(mega, dim3(grid), dim3(512), LDS_BYTES, stream, p); }
#endif
}
```

```cpp
#include <hip/hip_runtime.h>
#include <stdint.h>
#include <stdio.h>
#define MK_ONE_LAUNCH 1
#define MK_DUP_PH 0
#define MK_DUP_N 0
#define MK_DUP_SUB 0

typedef uint16_t bf16_t;
#define LAS __attribute__((address_space(3)))
#define GAS __attribute__((address_space(1)))

constexpr int D = 1024, NB = 8, S = 4096, T = NB * S, NMEM = 256;
constexpr int NIN = 3656, NINP = 3840;
constexpr int OFF_QA = 0, OFF_KA = 512, OFF_VA = 1024, OFF_QB = 1536, OFF_KB = 1792, OFF_VB = 2048;
constexpr int OFF_QC = 2304, OFF_KC = 2560, OFF_VC = 2816, OFF_QI = 3072, OFF_KI = 3584, OFF_WI = 3648;
constexpr int DFF = 2816, NE = 8, DFFE = 3584;
constexpr float ALPHA = 1.41421356237f;
constexpr float LN_EPS = 1e-5f, RMS_EPS = 1e-6f;
constexpr float LOG2E = 1.4426950408889634f;
constexpr int MAXROWS = 2 * T + NE * 256;
constexpr int PASS_TILES = MAXROWS / 256 / 2;
constexpr int PASS_ROWS = PASS_TILES * 256;
static_assert(((size_t)72 + 64) * 256 * DFFE * 2 <= (size_t)240 * 1024 * 1024 && MAXROWS / 256 - 192 <= 72, "the two MoE hidden buffers must fit BIG");
constexpr size_t MOE_HB1 = (size_t)72 * 256 * DFFE;

constexpr size_t MiB = 1u << 20;
constexpr size_t WS_CTL = 0;
constexpr size_t WS_WSM = 2 * MiB;
constexpr size_t WS_WBIG = 20 * MiB;
constexpr size_t WS_BIG = 188 * MiB;
constexpr size_t WS_ZB = WS_BIG + 176 * MiB;
constexpr size_t WS_B0 = 428 * MiB;
constexpr size_t WS_B1 = 492 * MiB;
constexpr size_t WS_XG = WS_B0;
constexpr size_t WS_KV = 560 * MiB;
constexpr size_t WS_MEMB = 568 * MiB;
constexpr size_t WS_END = 572 * MiB;
constexpr size_t WSM_WIN = 0, WSM_WOUT = (size_t)NINP * D, WSM_WQ = WSM_WOUT + (size_t)D * D, WSM_WO = WSM_WQ + (size_t)D * D, WSM_WKV = WSM_WO + (size_t)D * D;
static_assert((WSM_WKV + 2 * (size_t)D * D) * 2 <= 18 * MiB, "wsm");
constexpr size_t ISC_BATCH = (size_t)4096 * 2080;
constexpr int ISC_IN_WBIG = 5;
constexpr size_t OUT_MASK = (size_t)3 * ISC_BATCH * 4;
static_assert((size_t)ISC_IN_WBIG * ISC_BATCH * 4 <= 168 * MiB && OUT_MASK + (size_t)T * 512 <= (size_t)T * D * 4, "isc scratch");
constexpr size_t CT_BAR = 0;
constexpr size_t CT_CNT = 32 * 1024;
constexpr size_t CT_QCTR = 36 * 1024;
constexpr size_t CT_NORM = 108 * 1024;
constexpr size_t CT_LAM = 64 * 1024;
constexpr size_t CT_TILEE = 66 * 1024;
constexpr size_t CT_E0 = 128 * 1024;
constexpr size_t CT_E1 = CT_E0 + T * 4;
constexpr size_t CT_G0 = CT_E1 + T * 4;
constexpr size_t CT_G1 = CT_G0 + T * 4;
constexpr size_t CT_P0 = CT_G1 + T * 4;
constexpr size_t CT_P1 = CT_P0 + T * 4;
constexpr size_t CT_ROWTOK = CT_P1 + T * 4;
static_assert(CT_ROWTOK + MAXROWS * 4 <= 2 * MiB, "ctl");
constexpr size_t CTL_ZERO_BYTES = 64 * 1024;

constexpr int LDS_BYTES = 147456;
constexpr int LDS_MISC = 131072;

struct Params {
    const float *x, *mem, *w_in, *lq1, *lk1, *lq2, *lk2, *dgain, *relb, *w_out, *ln1g, *ln1b, *wq, *wk, *wv, *wo, *ln2g, *ln2b,
        *fw1, *fw3, *fw2, *router, *mw1, *mw3, *mw2, *ln3g, *ln3b;
    float* out;
    unsigned char* ws;
    int ph_lo, ph_hi;
    int sub, pad_;
};

typedef const __attribute__((address_space(4))) Params CParams;
__device__ __forceinline__ CParams* opqk(CParams* x) { asm volatile("" : "+s"(x)); return x; }
typedef float f32x4 __attribute__((ext_vector_type(4)));
typedef unsigned u32x4 __attribute__((ext_vector_type(4)));
typedef unsigned u32x2 __attribute__((ext_vector_type(2)));

__device__ __forceinline__ float bf2f(bf16_t v) { return __uint_as_float(((unsigned)v) << 16); }
__device__ __forceinline__ bf16_t f2bf(float f) { unsigned u = __float_as_uint(f); return (bf16_t)((u + 0x7fffu + ((u >> 16) & 1u)) >> 16); }
__device__ __forceinline__ unsigned pk2(float lo, float hi) { typedef float f2 __attribute__((ext_vector_type(2))); typedef __bf16 b2 __attribute__((ext_vector_type(2)));
    f2 v = {lo, hi}; b2 b = __builtin_convertvector(v, b2); return __builtin_bit_cast(unsigned, b); }
__device__ __forceinline__ float ldA(const float* p) { return *p; }
__device__ __forceinline__ float ldA(const bf16_t* p) { return bf2f(*p); }
__device__ __forceinline__ float wave_max(float v) { for (int o = 32; o > 0; o >>= 1) v = fmaxf(v, __shfl_xor(v, o)); return v; }
__device__ __forceinline__ float wave_sum(float v) { for (int o = 32; o > 0; o >>= 1) v += __shfl_xor(v, o); return v; }

__device__ __forceinline__ int tid_of(int wids) { int t = (wids << 6) | (int)__builtin_amdgcn_mbcnt_hi(~0u, __builtin_amdgcn_mbcnt_lo(~0u, 0u)); asm volatile("" : "+v"(t)); return t; }
#define TIDX tid_of(WIDS)

__device__ __forceinline__ unsigned char* opq(unsigned char* x) { asm volatile("" : "+s"(x)); return x; }
template <typename T_> __device__ __forceinline__ T_* asg(T_* x) { return x; }
#define WSX asg(opq(p.ws))

__device__ __forceinline__ int opq_i(int x) { asm volatile("" : "+s"(x)); return x; }
#define BIDX opq_i((int)blockIdx.x)
#define GDIM opq_i((int)gridDim.x)

namespace pg8 {
#define PG8_LAS __attribute__((address_space(3)))
typedef unsigned short bf16_t;
typedef short bf16x8 __attribute__((ext_vector_type(8)));
typedef float f32x4 __attribute__((ext_vector_type(4)));
typedef unsigned u32x4 __attribute__((ext_vector_type(4)));
constexpr int BM = 256, BK = 64, HALF = 128, HTB = HALF * BK * 2  , STAGE_BYTES = 8 * HTB, NXCD = 8, WGM = 8;

__host__ __device__ __forceinline__ int lds_byte(int r, int c) { const int st = (r >> 4) * 2 + (c >> 5), rr = r & 15, cc = c & 31, ob = rr * 64 + cc * 2; return st * 1024 + (ob ^ (((ob >> 9) & 1) << 5)); }
__host__ __device__ __forceinline__ void stage_rc(int b, int& R, int& C) { const int st = b / 1024, sb = b % 1024, swz = sb ^ (((sb >> 9) & 1) << 5); R = (st >> 1) * 16 + swz / 64; C = (st & 1) * 32 + (swz % 64) / 2; }
__host__ __device__ __forceinline__ int perm32(int rho) { const int n = rho >> 4, i = rho & 15; return 8 * (i >> 2) + 4 * n + (i & 3); }

struct Unit { int pm, pn; };
struct Gemm { const bf16_t* A; const bf16_t* Bt; int M, N, K; };

struct StaticOrder {
    int nM, nN, nwg, G, c;
    __host__ __device__ void init(int M, int N, int G_, int c_) { nM = M / BM; nN = N / BM; nwg = nM * nN; G = G_; c = c_; }
    __host__ __device__ __forceinline__ bool next(int i, Unit& u) const {
        const long L = (long)i * G + c; if (L >= nwg) return false;
        int wgid = (int)L; { const int q = nwg / NXCD, r = nwg % NXCD, xcd = wgid % NXCD, off = wgid / NXCD; wgid = (xcd < r ? xcd * (q + 1) : r * (q + 1) + (xcd - r) * q) + off; }
        const int nig = WGM * nN, gid = wgid / nig, fm = gid * WGM, gsz = (nM - fm) < WGM ? (nM - fm) : WGM;
        u.pm = fm + ((wgid % nig) % gsz); u.pn = (wgid % nig) / gsz; return true;
    }
    __device__ __forceinline__ void a_ready(const Unit&) const {}
    __device__ __forceinline__ void done(const Unit&) const {}
};


struct MoeOrder {
    const int* tile_e; int nvalid, nN, G, c;
    int x, skip;
    __device__ bool next(int i, Unit& u) const {
        const int r = i + (c < x ? skip : 0);
        const long L = r < skip ? (long)r * (G - x) + (c - x) : (long)skip * (G - x) + (long)(r - skip) * G + c; if (L >= (long)nvalid * nN) return false;
        const int pm = (int)(L / nN), pn = (int)(L % nN); const int e = __builtin_amdgcn_readfirstlane(tile_e[pm]);
        u.pm = pm; u.pn = e * nN + pn; return true;
    }
    __device__ __forceinline__ void a_ready(const Unit&) const {}
    __device__ __forceinline__ void done(const Unit&) const {}
};
struct EpiStore {
    static constexpr bool PERM = true, AFTER_DRAIN = false;
    bf16_t* O; int ldc; int nN;
    __device__ __forceinline__ void operator()(const f32x4 (&acc)[2][2][4][2], const Unit& u, int wr, int wc, int fr, int fq) const {
        const int row0 = u.pm * BM + wr * 64 + fr; const int pn = nN ? (u.pn % nN) : u.pn; const int col0 = pn * BM + wc * 32 + 8 * fq;
#pragma unroll
        for (int ai = 0; ai < 2; ++ai)
#pragma unroll
            for (int m = 0; m < 4; ++m) { bf16_t* rowp = O + (size_t)(row0 + ai * HALF + m * 16) * ldc + col0;
#pragma unroll
                for (int bj = 0; bj < 2; ++bj) { const f32x4 v0 = acc[ai][bj][m][0], v1 = acc[ai][bj][m][1];
                    u32x4 w; w.x = ::pk2(v0[0], v0[1]); w.y = ::pk2(v0[2], v0[3]); w.z = ::pk2(v1[0], v1[1]); w.w = ::pk2(v1[2], v1[3]);
                    *(u32x4*)(rowp + bj * HALF) = w; } }
    }
};
struct ProjKvOrder {
    StaticOrder so; int nproj, ng, cc, kv_pm0, kv_pn0;
    __device__ void init(int M, int N, int g_, int c_, int pm0, int pn0) { so.init(M, N, g_, c_); nproj = (M / BM) * (N / BM); ng = g_; cc = c_; kv_pm0 = pm0; kv_pn0 = pn0; }
    __device__ bool next(int i, Unit& u) const {
        const long L = (long)i * ng + cc;
        if (L < nproj) return so.next(i, u);
        const int r = (int)(L - nproj); if (r >= 64) return false;
        u.pm = kv_pm0 + (r >> 3); u.pn = kv_pn0 + (r & 7); return true;
    }
    __device__ __forceinline__ void a_ready(const Unit&) const {}
    __device__ __forceinline__ void done(const Unit&) const {}
};
struct EpiProjKv {
    static constexpr bool PERM = true, AFTER_DRAIN = false;
    bf16_t* O; int ldc; bf16_t* O2; int kv_pm0, kv_pn0;
    __device__ __forceinline__ void operator()(const f32x4 (&acc)[2][2][4][2], const Unit& u, int wr, int wc, int fr, int fq) const {
        const bool kv = u.pm >= kv_pm0;
        bf16_t* base = kv ? O2 : O; const int ld = kv ? 2048 : ldc; const int pm = kv ? u.pm - kv_pm0 : u.pm, pn = kv ? u.pn - kv_pn0 : u.pn;
        const int row0 = pm * BM + wr * 64 + fr, col0 = pn * BM + wc * 32 + 8 * fq;
#pragma unroll
        for (int ai = 0; ai < 2; ++ai)
#pragma unroll
            for (int m = 0; m < 4; ++m) { bf16_t* rowp = base + (size_t)(row0 + ai * HALF + m * 16) * ld + col0;
#pragma unroll
                for (int bj = 0; bj < 2; ++bj) { const f32x4 v0 = acc[ai][bj][m][0], v1 = acc[ai][bj][m][1];
                    u32x4 w; w.x = ::pk2(v0[0], v0[1]); w.y = ::pk2(v0[2], v0[3]); w.z = ::pk2(v1[0], v1[1]); w.w = ::pk2(v1[2], v1[3]);
                    *(u32x4*)(rowp + bj * HALF) = w; } }
    }
};
struct EpiResid {
    static constexpr bool PERM = true, AFTER_DRAIN = false;
    const bf16_t* resid; bf16_t* out;
    __device__ __forceinline__ void operator()(const f32x4 (&acc)[2][2][4][2], const Unit& u, int wr, int wc, int fr, int fq) const {
        const int row0 = u.pm * BM + wr * 64 + fr, col0 = u.pn * BM + wc * 32 + 8 * fq;
#pragma unroll
        for (int ai = 0; ai < 2; ++ai)
#pragma unroll
            for (int m = 0; m < 4; ++m) { const size_t off = (size_t)(row0 + ai * HALF + m * 16) * 1024 + col0;
#pragma unroll
                for (int bj = 0; bj < 2; ++bj) { const size_t o = off + bj * HALF; const u32x4 rb = *(const u32x4*)(resid + o);
                    const f32x4 v0 = acc[ai][bj][m][0], v1 = acc[ai][bj][m][1]; const float A = 1.41421356237f;
                    u32x4 w;
                    w.x = ::pk2(__uint_as_float(rb.x << 16) * A + v0[0], __uint_as_float(rb.x & 0xffff0000u) * A + v0[1]);
                    w.y = ::pk2(__uint_as_float(rb.y << 16) * A + v0[2], __uint_as_float(rb.y & 0xffff0000u) * A + v0[3]);
                    w.z = ::pk2(__uint_as_float(rb.z << 16) * A + v1[0], __uint_as_float(rb.z & 0xffff0000u) * A + v1[1]);
                    w.w = ::pk2(__uint_as_float(rb.w << 16) * A + v1[2], __uint_as_float(rb.w & 0xffff0000u) * A + v1[3]);
                    *(u32x4*)(out + o) = w; } }
    }
};
struct EpiSwiglu {
    static constexpr bool PERM = true, AFTER_DRAIN = false;
    bf16_t* O; int ldc; int nN;
    static __device__ __forceinline__ float sg(float g, float u) { return g * __builtin_amdgcn_rcpf(1.0f + __builtin_amdgcn_exp2f(-1.4426950408889634f * g)) * u; }
    __device__ __forceinline__ void operator()(const f32x4 (&acc)[2][2][4][2], const Unit& u, int wr, int wc, int fr, int fq) const {
        const int row0 = u.pm * BM + wr * 64 + fr; const int pn = nN ? (u.pn % nN) : u.pn; const int col0 = pn * HALF + wc * 32 + 8 * fq;
#pragma unroll
        for (int ai = 0; ai < 2; ++ai)
#pragma unroll
            for (int m = 0; m < 4; ++m) { bf16_t* rowp = O + (size_t)(row0 + ai * HALF + m * 16) * ldc + col0;
                const f32x4 g0 = acc[ai][0][m][0], g1 = acc[ai][0][m][1], u0 = acc[ai][1][m][0], u1 = acc[ai][1][m][1];
                u32x4 w; w.x = ::pk2(sg(g0[0], u0[0]), sg(g0[1], u0[1])); w.y = ::pk2(sg(g0[2], u0[2]), sg(g0[3], u0[3]));
                w.z = ::pk2(sg(g1[0], u1[0]), sg(g1[1], u1[1])); w.w = ::pk2(sg(g1[2], u1[2]), sg(g1[3], u1[3]));
                *(u32x4*)rowp = w; }
    }
};

template <class Epi, class Sched, bool ALIGN_EPI = false, bool SP2 = false>
__device__ __forceinline__ void gemm_phase(PG8_LAS unsigned char* lds, const Gemm g, const Sched& S, const Epi& E, int WIDS) {
    int tid_ = ::tid_of(WIDS); asm volatile("" : "+v"(tid_));
    const int tid = tid_, wid = __builtin_amdgcn_readfirstlane(tid >> 6), lane = tid & 63, wr = wid >> 2, wc = wid & 3, fr = lane & 15, fq = lane >> 4;
    const int K = g.K, nt = K / BK;
    unsigned voffA[2], voffB[2];
#pragma unroll
    for (int i = 0; i < 2; ++i) { int R, C; stage_rc(tid * 16 + i * 8192, R, C); const int Rb = Epi::PERM ? ((R & ~31) + perm32(R & 31)) : R;
        voffA[i] = (unsigned)(R * K + C) * 2u; voffB[i] = (unsigned)(Rb * K + C) * 2u; }
    const size_t kstep = (size_t)(BK * 2);
    const size_t hstep = (size_t)HALF * K * 2;
    const size_t tstep = 2 * hstep;
    const unsigned ldsw = (unsigned)wid * 1024u;
    const int aoff = lds_byte(wr * 64 + fr, fq * 8), boff = lds_byte(wc * 32 + fr, fq * 8);
#define PG8_SA(b, h) (((b) * 2 + (h)) * HTB)
#define PG8_SB(b, h) ((4 + (b) * 2 + (h)) * HTB)
#define PG8_STAGE(bufoff, gbase, voff) do { _Pragma("unroll") for (int _i = 0; _i < 2; ++_i) \
        __builtin_amdgcn_global_load_lds((const unsigned*)((const char*)(gbase) + (voff)[_i]), (PG8_LAS unsigned*)(lds + (bufoff) + ldsw + _i * 8192), 16, 0, 0); } while (0)
#define PG8_LDA(dst, b, h) do { _Pragma("unroll") for (int m = 0; m < 4; ++m) _Pragma("unroll") for (int k = 0; k < 2; ++k) dst[m][k] = *(const PG8_LAS bf16x8*)(lds + PG8_SA(b, h) + aoff + m * 2048 + k * 1024); } while (0)
#define PG8_LDB(dst, b, h) do { _Pragma("unroll") for (int n = 0; n < 2; ++n) _Pragma("unroll") for (int k = 0; k < 2; ++k) dst[n][k] = *(const PG8_LAS bf16x8*)(lds + PG8_SB(b, h) + boff + n * 2048 + k * 1024); } while (0)
#define PG8_MMA(ai, bj, At, Bt) do { __builtin_amdgcn_s_setprio(1); _Pragma("unroll") for (int m = 0; m < 4; ++m) _Pragma("unroll") for (int n = 0; n < 2; ++n) _Pragma("unroll") for (int k = 0; k < 2; ++k) \
        acc[ai][bj][m][n] = __builtin_amdgcn_mfma_f32_16x16x32_bf16(Bt[n][k], At[m][k], acc[ai][bj][m][n], 0, 0, 0); __builtin_amdgcn_s_setprio(0); } while (0)
#define PG8_WAIT_V(n) asm volatile("s_waitcnt vmcnt(" #n ")" ::: "memory")
#define PG8_WAIT_L(n) asm volatile("s_waitcnt lgkmcnt(" #n ")" ::: "memory")
#define PG8_BAR __builtin_amdgcn_s_barrier()
#define PG8_SCHED __builtin_amdgcn_sched_barrier(0)
    Unit cur, nxt; int ui = 0;
    if (!S.next(0, cur)) return;
    f32x4 acc[2][2][4][2];
#pragma unroll
    for (int a = 0; a < 2; ++a)
#pragma unroll
        for (int b = 0; b < 2; ++b)
#pragma unroll
            for (int m = 0; m < 4; ++m)
#pragma unroll
                for (int n = 0; n < 2; ++n) acc[a][b][m][n] = (f32x4){0.f, 0.f, 0.f, 0.f};
    bf16x8 At[4][2], B0[2][2], B1[2][2];
    const char* cA = (const char*)g.A + (size_t)cur.pm * tstep; const char* cB = (const char*)g.Bt + (size_t)cur.pn * tstep;
    S.a_ready(cur);
    if constexpr (SP2) {
        PG8_STAGE(PG8_SB(0, 0), cB, voffB); PG8_STAGE(PG8_SB(0, 1), cB + hstep, voffB); PG8_STAGE(PG8_SA(0, 0), cA, voffA); PG8_STAGE(PG8_SA(0, 1), cA + hstep, voffA);
        if (wr == 1) PG8_BAR;
        PG8_WAIT_V(2); PG8_BAR;
        PG8_STAGE(PG8_SB(1, 0), cB + kstep, voffB); PG8_STAGE(PG8_SA(1, 0), cA + kstep, voffA); PG8_STAGE(PG8_SB(1, 1), cB + hstep + kstep, voffB);
        PG8_WAIT_V(6); PG8_BAR;
    } else {
        PG8_STAGE(PG8_SB(0, 0), cB, voffB); PG8_STAGE(PG8_SA(0, 0), cA, voffA); PG8_STAGE(PG8_SB(0, 1), cB + hstep, voffB); PG8_STAGE(PG8_SA(0, 1), cA + hstep, voffA);
        if (wr == 1) PG8_BAR;
        PG8_WAIT_V(4); PG8_BAR;
        PG8_STAGE(PG8_SB(1, 0), cB + kstep, voffB); PG8_STAGE(PG8_SA(1, 0), cA + kstep, voffA); PG8_STAGE(PG8_SB(1, 1), cB + hstep + kstep, voffB);
        PG8_WAIT_V(6); PG8_BAR;
    }
    for (;;) {
        const bool has_next = S.next(ui + 1, nxt);
        const char* nA = has_next ? (const char*)g.A + (size_t)nxt.pm * tstep : cA; const char* nB = has_next ? (const char*)g.Bt + (size_t)nxt.pn * tstep : cB;
        for (int t = 0; t < nt; t += 2) {
            const bool last = (t == nt - 2);
            const char* a1 = cA + (size_t)(t + 1) * kstep;
            const char* a2 = last ? nA : cA + (size_t)(t + 2) * kstep; const char* b2 = last ? nB : cB + (size_t)(t + 2) * kstep;
            const char* a3 = a2 + kstep; const char* b3 = b2 + kstep;
            if (last && has_next) S.a_ready(nxt);
            if constexpr (SP2) {
            PG8_LDB(B0, 0, 0); PG8_LDB(B1, 0, 1); PG8_SCHED; PG8_LDA(At, 0, 0); PG8_STAGE(PG8_SA(1, 1), a1 + hstep, voffA);
            PG8_WAIT_V(8); PG8_WAIT_L(0); PG8_BAR; PG8_MMA(0, 0, At, B0); PG8_MMA(0, 1, At, B1); PG8_BAR; PG8_SCHED;
            PG8_LDA(At, 0, 1); PG8_STAGE(PG8_SB(0, 0), b2, voffB); PG8_STAGE(PG8_SB(0, 1), b2 + hstep, voffB); PG8_STAGE(PG8_SA(0, 0), a2, voffA);
            PG8_WAIT_V(8); PG8_WAIT_L(0); PG8_BAR; PG8_MMA(1, 0, At, B0); PG8_MMA(1, 1, At, B1); PG8_BAR; PG8_SCHED;
            PG8_LDB(B0, 1, 0); PG8_LDB(B1, 1, 1); PG8_SCHED; PG8_LDA(At, 1, 0); PG8_STAGE(PG8_SA(0, 1), a2 + hstep, voffA);
            PG8_WAIT_V(8); PG8_WAIT_L(0); PG8_BAR; PG8_MMA(0, 0, At, B0); PG8_MMA(0, 1, At, B1); PG8_BAR; PG8_SCHED;
            PG8_LDA(At, 1, 1); PG8_STAGE(PG8_SB(1, 0), b3, voffB); PG8_STAGE(PG8_SB(1, 1), b3 + hstep, voffB); PG8_STAGE(PG8_SA(1, 0), a3, voffA);
            PG8_WAIT_V(8); PG8_WAIT_L(0); PG8_BAR; PG8_MMA(1, 0, At, B0); PG8_MMA(1, 1, At, B1); PG8_BAR; PG8_SCHED;
            } else {
            PG8_LDB(B0, 0, 0); PG8_SCHED; PG8_LDA(At, 0, 0); PG8_STAGE(PG8_SA(1, 1), a1 + hstep, voffA);
            PG8_WAIT_L(8); PG8_BAR; PG8_WAIT_L(0); PG8_MMA(0, 0, At, B0); PG8_BAR; PG8_SCHED;
            PG8_LDB(B1, 0, 1); PG8_STAGE(PG8_SB(0, 0), b2, voffB);
            PG8_BAR; PG8_WAIT_L(0); PG8_MMA(0, 1, At, B1); PG8_BAR;
            PG8_LDA(At, 0, 1); PG8_STAGE(PG8_SA(0, 0), a2, voffA);
            PG8_BAR; PG8_WAIT_L(0); PG8_MMA(1, 0, At, B0); PG8_BAR; PG8_SCHED;
            PG8_STAGE(PG8_SB(0, 1), b2 + hstep, voffB);
            PG8_WAIT_V(6); PG8_BAR; PG8_MMA(1, 1, At, B1); PG8_BAR;
            PG8_LDB(B0, 1, 0); PG8_SCHED; PG8_LDA(At, 1, 0); PG8_STAGE(PG8_SA(0, 1), a2 + hstep, voffA);
            PG8_WAIT_L(8); PG8_BAR; PG8_WAIT_L(0); PG8_MMA(0, 0, At, B0); PG8_BAR; PG8_SCHED;
            PG8_LDB(B1, 1, 1); PG8_STAGE(PG8_SB(1, 0), b3, voffB);
            PG8_BAR; PG8_WAIT_L(0); PG8_MMA(0, 1, At, B1); PG8_BAR;
            PG8_LDA(At, 1, 1); PG8_STAGE(PG8_SA(1, 0), a3, voffA);
            PG8_BAR; PG8_WAIT_L(0); PG8_MMA(1, 0, At, B0); PG8_BAR; PG8_SCHED;
            PG8_STAGE(PG8_SB(1, 1), b3 + hstep, voffB);
            PG8_WAIT_V(6); PG8_BAR; PG8_MMA(1, 1, At, B1); PG8_BAR;
            }
        }
        if constexpr (ALIGN_EPI) { if (wr == 0) PG8_BAR; }
        if constexpr (!Epi::AFTER_DRAIN) { E(acc, cur, wr, wc, fr, fq); S.done(cur); }
        if (!has_next) break;
#pragma unroll
        for (int a = 0; a < 2; ++a)
#pragma unroll
            for (int b = 0; b < 2; ++b)
#pragma unroll
                for (int m = 0; m < 4; ++m)
#pragma unroll
                    for (int n = 0; n < 2; ++n) acc[a][b][m][n] = (f32x4){0.f, 0.f, 0.f, 0.f};
        cur = nxt; cA = nA; cB = nB; ++ui;
        if constexpr (ALIGN_EPI) { if (wr == 1) PG8_BAR; }
    }
    PG8_WAIT_V(0);
    if constexpr (!ALIGN_EPI) { if (wr == 0) PG8_BAR; }
    PG8_BAR;
    if constexpr (Epi::AFTER_DRAIN) { E.fused(acc, cur, wr, wc, fr, fq, lds, wid, lane); S.done(cur); }
#undef PG8_SA
#undef PG8_SB
#undef PG8_STAGE
#undef PG8_LDA
#undef PG8_LDB
#undef PG8_MMA
#undef PG8_WAIT_V
#undef PG8_WAIT_L
#undef PG8_BAR
#undef PG8_SCHED
}
}

#define XB_TMO      128
#define XB_XCNT(j)  (256  + 64 * (j))
#define XB_XSUB(j)  (1280 + 64 * (j))
#define XB_XGEN(j)  (2304 + 64 * (j))
#define XB_TOP      3328
#define XB_TOPGEN   3392
#define XCD_BAR_WORDS 3456
#define XB_SPIN_CAP (1u << 18)

__device__ __forceinline__ unsigned xb_ld(unsigned* p)              { return __hip_atomic_load(p, __ATOMIC_RELAXED, __HIP_MEMORY_SCOPE_AGENT); }
__device__ __forceinline__ unsigned xb_add(unsigned* p, unsigned v) { return __hip_atomic_fetch_add(p, v, __ATOMIC_RELAXED, __HIP_MEMORY_SCOPE_AGENT); }
__device__ __forceinline__ unsigned xb_xcc_id() { return (unsigned)__builtin_amdgcn_s_getreg((3 << 11) | 20) & 0xFu; }
#define XB_SPIN(cond, bar) do { unsigned _sp = 0; while (cond) { __builtin_amdgcn_s_sleep(1); \
    if ((++_sp & 255u) == 0u) { if (xb_ld(&(bar)[XB_TMO])) break; if (_sp > XB_SPIN_CAP) { atomicAdd(&(bar)[XB_TMO], 1u); break; } } } } while (0)

struct XcdBarrier {
    unsigned* bar; unsigned x;
    volatile LAS unsigned* st;
};

__device__ __forceinline__ XcdBarrier xcd_barrier_post(unsigned* bar, volatile LAS unsigned* st, int WIDS) {
    XcdBarrier b; b.bar = bar; b.x = xb_xcc_id(); b.st = st;
    if (tid_of(WIDS) == 0) (void)xb_add(&bar[XB_XCNT(b.x)], 1u);
    return b;
}
__device__ __forceinline__ void xcd_barrier_complete(unsigned* bar, unsigned x, unsigned& nloc, unsigned& nx) {
    const unsigned G = gridDim.x * gridDim.y * gridDim.z;
    unsigned sum, cnt, mine, sp = 0u;
    for (;;) {
        sum = 0u; cnt = 0u; mine = 0u;
#pragma unroll
        for (unsigned j = 0; j < 16; ++j) { const unsigned c = xb_ld(&bar[XB_XCNT(j)]); sum += c; cnt += (c > 0u) ? 1u : 0u; mine = (j == x) ? c : mine; }
        if (sum == G) break;
        __builtin_amdgcn_s_sleep(1);
        if ((++sp & 255u) == 0u) { if (xb_ld(&bar[XB_TMO])) break; if (sp > XB_SPIN_CAP) { atomicAdd(&bar[XB_TMO], 1u); break; } }
    }
    nloc = mine > 0u ? mine : 1u; nx = cnt > 0u ? cnt : 1u;
}

__device__ __forceinline__ void xcd_barrier(const XcdBarrier& b, int WIDS) {
    asm volatile("s_waitcnt vmcnt(0)" ::: "memory");
    __syncthreads();
    if (tid_of(WIDS) == 0) {
        unsigned* bar = b.bar;
        __builtin_amdgcn_s_waitcnt(0);
        unsigned nloc = b.st[0], nx = b.st[1];
        if (nloc == 0u) { xcd_barrier_complete(bar, b.x, nloc, nx); b.st[0] = nloc; b.st[1] = nx; }
        const unsigned old = xb_add(&bar[XB_XSUB(b.x)], 1u);
        const unsigned gen = old / nloc;
        if (old + 1u == (gen + 1u) * nloc) {
            __builtin_amdgcn_fence(__ATOMIC_RELEASE, "agent");
            asm volatile("s_waitcnt vmcnt(0)" ::: "memory");
            const unsigned og = xb_add(&bar[XB_TOP], 1u);
            const unsigned tg = og / nx;
            if (og + 1u == (tg + 1u) * nx) xb_add(&bar[XB_TOPGEN], 1u);
            else XB_SPIN(xb_ld(&bar[XB_TOPGEN]) == tg, bar);
            __builtin_amdgcn_fence(__ATOMIC_ACQUIRE, "agent");
            xb_add(&bar[XB_XGEN(b.x)], 1u);
            asm volatile("s_waitcnt vmcnt(0)" ::: "memory");
        } else {
            XB_SPIN(xb_ld(&bar[XB_XGEN(b.x)]) == gen, bar);
            __builtin_amdgcn_fence(__ATOMIC_ACQUIRE, "agent");
            asm volatile("s_waitcnt vmcnt(0)" ::: "memory");
        }
    }
    __syncthreads();
}

struct CvtJob { const float* src; bf16_t* dst; int K, N, Npad, G, gstride, off; };
__device__ __forceinline__ void cvt_job(const CvtJob j, float* tile  , int WIDS, int& rr) {
    const int tid = TIDX, nkt = j.K / 64, nnt = j.Npad / 256, G = GDIM, nit = nkt * nnt;
    for (int item = (BIDX + G - rr % G) % G; item < nit; item += G) {
        const int kt = item % nkt, nt = item / nkt, k0 = kt * 64, n0 = nt * 256;
        f32x4 v[8];
        { const int n = (tid & 63) * 4; const float* sp = j.src + (size_t)(k0 + (tid >> 6)) * j.N + n0 + n; const bool ok = n0 + n < j.N;
#pragma unroll
          for (int q = 0; q < 8; ++q) { v[q] = (f32x4){0.f, 0.f, 0.f, 0.f}; if (ok) v[q] = *(const f32x4*)(sp + (size_t)(8 * q) * j.N); } }
        __syncthreads();
        { float* tp = tile + (tid >> 6) * 257 + (tid & 63) * 4;
#pragma unroll
          for (int q = 0; q < 8; ++q) { tp[q * 8 * 257] = v[q][0]; tp[q * 8 * 257 + 1] = v[q][1]; tp[q * 8 * 257 + 2] = v[q][2]; tp[q * 8 * 257 + 3] = v[q][3]; } }
        __syncthreads();
#pragma unroll
        for (int ps = 0; ps < 4; ++ps) {
            const int jb = tid + 512 * ps, n = jb >> 3, kc = (jb & 7) * 8, ng = n0 + n; const float* tr = tile + kc * 257 + n;
            u32x4 w; w.x = pk2(tr[0], tr[257]); w.y = pk2(tr[2 * 257], tr[3 * 257]); w.z = pk2(tr[4 * 257], tr[5 * 257]); w.w = pk2(tr[6 * 257], tr[7 * 257]);
            const size_t row = (size_t)(ng / j.G) * j.gstride + j.off + (ng % j.G);
            *(u32x4*)(j.dst + row * j.K + k0 + kc) = w;
        }
    }
    rr += nit;
}
constexpr int GID = 1 << 30;

__device__ __forceinline__ void ph_prologue(CParams& p, int WIDS) {
    bf16_t* Hb = (bf16_t*)(WSX + WS_B0); bf16_t* Mb = (bf16_t*)(WSX + WS_MEMB);
    const size_t g = (size_t)BIDX * 512 + TIDX, gs = (size_t)GDIM * 512;
    for (size_t i = g; i < (size_t)T * D / 4; i += gs) { const f32x4 v = ((const f32x4*)asg(p.x))[i]; u32x2 w; w.x = pk2(v[0], v[1]); w.y = pk2(v[2], v[3]); ((u32x2*)Hb)[i] = w; }
    for (size_t i = g; i < (size_t)NB * NMEM * D / 4; i += gs) { const f32x4 v = ((const f32x4*)asg(p.mem))[i]; u32x2 w; w.x = pk2(v[0], v[1]); w.y = pk2(v[2], v[3]); ((u32x2*)Mb)[i] = w; }
    if (BIDX == 0 && TIDX < 2) {
        const int l = TIDX; float a = 0.f, b = 0.f;
        for (int i = 0; i < 64; ++i) { a += asg(p.lq1)[l * 64 + i] * asg(p.lk1)[l * 64 + i]; b += asg(p.lq2)[l * 64 + i] * asg(p.lk2)[l * 64 + i]; }
        const float lam_init = 0.8f - 0.6f * expf(-0.3f * (float)l);
        float* lam = (float*)(WSX + CT_LAM); lam[l * 2] = expf(a) - expf(b) + lam_init; lam[l * 2 + 1] = lam_init;
    }
}
__device__ __forceinline__ void ph_prep_small(CParams& p, int layer, float* lds, int WIDS) {
    int rr = 0;
    bf16_t* W = (bf16_t*)(WSX + WS_WSM); const size_t DD = (size_t)D * D;
    cvt_job(CvtJob{asg(p.w_in) + (size_t)layer * D * NIN, W + WSM_WIN, D, NIN, NINP, GID, 0, 0}, lds, WIDS, rr);
    cvt_job(CvtJob{asg(p.w_out) + layer * DD, W + WSM_WOUT, D, D, D, GID, 0, 0}, lds, WIDS, rr);
    cvt_job(CvtJob{asg(p.wq) + layer * DD, W + WSM_WQ, D, D, D, GID, 0, 0}, lds, WIDS, rr);
    cvt_job(CvtJob{asg(p.wo) + layer * DD, W + WSM_WO, D, D, D, GID, 0, 0}, lds, WIDS, rr);
    cvt_job(CvtJob{asg(p.wk) + layer * DD, W + WSM_WKV, D, D, D, GID, 0, 0}, lds, WIDS, rr);
    cvt_job(CvtJob{asg(p.wv) + layer * DD, W + WSM_WKV + DD, D, D, D, GID, 0, 0}, lds, WIDS, rr);
}
constexpr size_t WB_W2 = (size_t)2 * DFF * D;
constexpr size_t WB_W2E = (size_t)NE * 2 * DFFE * D;
__device__ __forceinline__ void ph_prep_big(CParams& p, int layer, float* lds, int WIDS) {
    bf16_t* W = (bf16_t*)(WSX + WS_WBIG); int rr = 0;
    if (layer == 0) {
        cvt_job(CvtJob{asg(p.fw1), W, D, DFF, DFF, 128, 256, 0}, lds, WIDS, rr);
        cvt_job(CvtJob{asg(p.fw3), W, D, DFF, DFF, 128, 256, 128}, lds, WIDS, rr);
        cvt_job(CvtJob{asg(p.fw2), W + WB_W2, DFF, D, D, GID, 0, 0}, lds, WIDS, rr);
    } else {
        for (int e = 0; e < NE; ++e) {
            cvt_job(CvtJob{asg(p.mw1) + (size_t)e * D * DFFE, W + (size_t)e * 2 * DFFE * D, D, DFFE, DFFE, 128, 256, 0}, lds, WIDS, rr);
            cvt_job(CvtJob{asg(p.mw3) + (size_t)e * D * DFFE, W + (size_t)e * 2 * DFFE * D, D, DFFE, DFFE, 128, 256, 128}, lds, WIDS, rr);
            cvt_job(CvtJob{asg(p.mw2) + (size_t)e * DFFE * D, W + WB_W2E + (size_t)e * D * DFFE, DFFE, D, D, GID, 0, 0}, lds, WIDS, rr);
        }
    }
}

__device__ __forceinline__ void ph_layernorm(CParams& p, const float* g, const float* b, int WIDS) {
    const bf16_t* X = (const bf16_t*)(WSX + WS_ZB); bf16_t* Hb = (bf16_t*)(WSX + WS_B0);
    const int lane = TIDX & 63, w = TIDX >> 6;
    f32x4 gv[4], bv[4];
#pragma unroll
    for (int j = 0; j < 4; ++j) { gv[j] = ((const f32x4*)g)[64 * j + lane]; bv[j] = ((const f32x4*)b)[64 * j + lane]; }
    for (int row = BIDX * 8 + w; row < T; row += GDIM * 8) {
        const u32x2* xr = (const u32x2*)(X + (size_t)row * D) + lane; f32x4 v[4]; float s = 0.f;
#pragma unroll
        for (int j = 0; j < 4; ++j) { const u32x2 z = xr[64 * j]; v[j] = (f32x4){__uint_as_float(z.x << 16), __uint_as_float(z.x & 0xffff0000u), __uint_as_float(z.y << 16), __uint_as_float(z.y & 0xffff0000u)}; s += (v[j][0] + v[j][1]) + (v[j][2] + v[j][3]); }
        const float mu = wave_sum(s) * (1.0f / D); float q = 0.f;
#pragma unroll
        for (int j = 0; j < 4; ++j) { v[j] = v[j] - mu; q += (v[j][0] * v[j][0] + v[j][1] * v[j][1]) + (v[j][2] * v[j][2] + v[j][3] * v[j][3]); }
        const float rstd = rsqrtf(wave_sum(q) * (1.0f / D) + LN_EPS);
        u32x2* hb = (u32x2*)(Hb + (size_t)row * D) + lane;
#pragma unroll
        for (int j = 0; j < 4; ++j) { const f32x4 y = v[j] * rstd * gv[j] + bv[j]; u32x2 w2; w2.x = pk2(y[0], y[1]); w2.y = pk2(y[2], y[3]); hb[64 * j] = w2; }
    }
}
constexpr size_t CT_BLKCNT = 96 * 1024;
__device__ __forceinline__ void ph_ln_router(CParams& p, const float* g, const float* b, LAS unsigned char* lds, int WIDS) {
    float* X = asg(p.out); const bf16_t* Z = (const bf16_t*)(WSX + WS_ZB); const int tid = TIDX, lane = tid & 63, w = tid >> 6, bid = BIDX, G = GDIM, TPB = (T + G - 1) / G;
    int* e0 = (int*)(WSX + CT_E0); int* e1 = (int*)(WSX + CT_E1); float* g0 = (float*)(WSX + CT_G0); float* g1 = (float*)(WSX + CT_G1);
    LAS float* R = (LAS float*)lds;
    LAS int* lc = (LAS int*)(lds + 32768);
    __syncthreads();
    for (int i = tid; i < 8 * D; i += 512) R[(i & 7) * D + (i >> 3)] = asg(p.router)[i];
    if (tid < 8) lc[tid] = 0;
    __syncthreads();
    f32x4 gv[4], bv[4];
#pragma unroll
    for (int j = 0; j < 4; ++j) { gv[j] = ((const f32x4*)g)[64 * j + lane]; bv[j] = ((const f32x4*)b)[64 * j + lane]; }
    for (int tl = w; tl < TPB; tl += 8) {
        const int row = bid * TPB + tl; if (row >= T) break;
        f32x4* xr = (f32x4*)(X + (size_t)row * D) + lane; const u32x2* zr = (const u32x2*)(Z + (size_t)row * D) + lane; f32x4 v[4]; float s = 0.f;
#pragma unroll
        for (int j = 0; j < 4; ++j) { const u32x2 z = zr[64 * j]; v[j] = (f32x4){__uint_as_float(z.x << 16), __uint_as_float(z.x & 0xffff0000u), __uint_as_float(z.y << 16), __uint_as_float(z.y & 0xffff0000u)}; s += (v[j][0] + v[j][1]) + (v[j][2] + v[j][3]); }
        const float mu = wave_sum(s) * (1.0f / D); float q = 0.f;
#pragma unroll
        for (int j = 0; j < 4; ++j) { v[j] = v[j] - mu; q += (v[j][0] * v[j][0] + v[j][1] * v[j][1]) + (v[j][2] * v[j][2] + v[j][3] * v[j][3]); }
        const float rstd = rsqrtf(wave_sum(q) * (1.0f / D) + LN_EPS);
#pragma unroll
        for (int j = 0; j < 4; ++j) { v[j] = v[j] * rstd * gv[j] + bv[j]; xr[64 * j] = v[j]; }
        float lg[8];
#pragma unroll
        for (int e = 0; e < 8; ++e) { float a = 0.f;
#pragma unroll
            for (int j = 0; j < 4; ++j) { const f32x4 r = *(const LAS f32x4*)(R + e * D + 256 * j + 4 * lane); a += (v[j][0] * r[0] + v[j][1] * r[1]) + (v[j][2] * r[2] + v[j][3] * r[3]); }
            lg[e] = wave_sum(a); }
        if (lane == 0) {
            int i0 = 0; float b0 = lg[0];
#pragma unroll
            for (int e = 1; e < 8; ++e) if (lg[e] > b0) { b0 = lg[e]; i0 = e; }
            int i1 = -1; float b1 = -INFINITY;
#pragma unroll
            for (int e = 0; e < 8; ++e) if (e != i0 && lg[e] > b1) { b1 = lg[e]; i1 = e; }
            const float a = 1.0f / (1.0f + expf(b1 - b0));
            e0[row] = i0; e1[row] = i1; g0[row] = a; g1[row] = 1.0f - a;
            (void)__hip_atomic_fetch_add(lc + i0, 1, __ATOMIC_RELAXED, __HIP_MEMORY_SCOPE_WORKGROUP); (void)__hip_atomic_fetch_add(lc + i1, 1, __ATOMIC_RELAXED, __HIP_MEMORY_SCOPE_WORKGROUP);
        }
    }
    __syncthreads();
    if (tid < 8) ((int*)(WSX + CT_BLKCNT))[bid * 8 + tid] = lc[tid];
    __syncthreads();
}
__device__ __forceinline__ void ph_scatter(CParams& p, LAS unsigned char* lds, int WIDS) {
    const int tid = TIDX, lane = tid & 63, w = tid >> 6, bid = BIDX, G = GDIM, TPB = (T + G - 1) / G;
    const int* blk = (const int*)(WSX + CT_BLKCNT); int* cnt = (int*)(WSX + CT_CNT);
    LAS int* tot = (LAS int*)lds; LAS int* pre = tot + 8; LAS int* off = pre + 8;
    __syncthreads();
    { int t = 0, pb = 0; for (int bb = lane; bb < G; bb += 64) { const int c = blk[bb * 8 + w]; t += c; if (bb < bid) pb += c; }
#pragma unroll
      for (int o = 32; o > 0; o >>= 1) { t += __shfl_xor(t, o); pb += __shfl_xor(pb, o); }
      if (lane == 0) { tot[w] = t; pre[w] = pb; } }
    __syncthreads();
    if (tid == 0) { int o = 0; for (int e = 0; e < 8; ++e) { off[e] = o; o += ((tot[e] + 255) / 256) * 256; } off[8] = o; }
    __syncthreads();
    if (bid == 0) { int* tile_e = (int*)(WSX + CT_TILEE); if (tid < 8) cnt[tid] = tot[tid];
        for (int i = tid; i < MAXROWS / 256; i += 512) { int e = -1; for (int q = 0; q < 8; ++q) if (i * 256 >= off[q] && i * 256 < off[q + 1]) e = q; tile_e[i] = e; } }
    const int* e0 = (const int*)(WSX + CT_E0); const int* e1 = (const int*)(WSX + CT_E1);
    int* p0 = (int*)(WSX + CT_P0); int* p1 = (int*)(WSX + CT_P1);
    LAS int* posl = off + 16;
    int running = off[w] + pre[w];
    for (int n0 = 0; n0 < 2 * TPB; n0 += 64) {
        const int n = n0 + lane, tok = bid * TPB + (n >> 1), slot = n & 1;
        const bool ok = (n < 2 * TPB) && tok < T; const int e = ok ? (slot ? e1[tok] : e0[tok]) : -1;
        const unsigned long long m = __ballot(e == w);
        if (e == w) { const int pos = running + __popcll(m & ((1ull << lane) - 1ull)); if (slot) p1[tok] = pos; else p0[tok] = pos; posl[n] = pos; }
        running += __popcll(m);
    }
    __syncthreads();
    bf16_t* Xg = (bf16_t*)(WSX + WS_XG); const float* H = asg(p.out);
    for (int tl = w; tl < TPB; tl += 8) {
        const int tok = bid * TPB + tl; if (tok >= T) break;
        const f32x4* h = (const f32x4*)(H + (size_t)tok * D) + lane;
        u32x2* o0 = (u32x2*)(Xg + (size_t)posl[2 * tl] * D) + lane; u32x2* o1 = (u32x2*)(Xg + (size_t)posl[2 * tl + 1] * D) + lane;
#pragma unroll
        for (int j = 0; j < 4; ++j) { const f32x4 v = h[64 * j]; u32x2 w2; w2.x = pk2(v[0], v[1]); w2.y = pk2(v[2], v[3]); o0[64 * j] = w2; o1[64 * j] = w2; }
    }
    for (int e = 0; e < 8; ++e)
        for (int r = off[e] + tot[e] + bid * 8 + w; r < off[e + 1]; r += G * 8) { u32x2* o = (u32x2*)(Xg + (size_t)r * D) + lane;
#pragma unroll
            for (int j = 0; j < 4; ++j) { u32x2 z; z.x = 0u; z.y = 0u; o[64 * j] = z; } }
    __syncthreads();
}
__device__ __forceinline__ void ph_combine_ln(CParams& p, const float* g, const float* b, int WIDS) {
    const bf16_t* Yr = (const bf16_t*)(WSX + WS_XG); float* X = asg(p.out);
    const int* p0 = (const int*)(WSX + CT_P0); const int* p1 = (const int*)(WSX + CT_P1); const float* g0 = (const float*)(WSX + CT_G0); const float* g1 = (const float*)(WSX + CT_G1);
    const int lane = TIDX & 63, w = TIDX >> 6;
    f32x4 gv[4], bv[4];
#pragma unroll
    for (int j = 0; j < 4; ++j) { gv[j] = ((const f32x4*)g)[64 * j + lane]; bv[j] = ((const f32x4*)b)[64 * j + lane]; }
    for (int tok = BIDX * 8 + w; tok < T; tok += GDIM * 8) {
        const u32x2* ya = (const u32x2*)(Yr + (size_t)p0[tok] * D) + lane; const u32x2* yb = (const u32x2*)(Yr + (size_t)p1[tok] * D) + lane; const float ga = g0[tok], gb = g1[tok];
        f32x4* xr = (f32x4*)(X + (size_t)tok * D) + lane; f32x4 v[4]; float s = 0.f;
#pragma unroll
        for (int j = 0; j < 4; ++j) { const f32x4 h = xr[64 * j]; const u32x2 a = ya[64 * j], c = yb[64 * j];
            f32x4 fa = {__uint_as_float(a.x << 16), __uint_as_float(a.x & 0xffff0000u), __uint_as_float(a.y << 16), __uint_as_float(a.y & 0xffff0000u)};
            f32x4 fc = {__uint_as_float(c.x << 16), __uint_as_float(c.x & 0xffff0000u), __uint_as_float(c.y << 16), __uint_as_float(c.y & 0xffff0000u)};
            v[j] = h * ALPHA + fa * ga + fc * gb; s += (v[j][0] + v[j][1]) + (v[j][2] + v[j][3]); }
        const float mu = wave_sum(s) * (1.0f / D); float q = 0.f;
#pragma unroll
        for (int j = 0; j < 4; ++j) { v[j] = v[j] - mu; q += (v[j][0] * v[j][0] + v[j][1] * v[j][1]) + (v[j][2] * v[j][2] + v[j][3] * v[j][3]); }
        const float rstd = rsqrtf(wave_sum(q) * (1.0f / D) + LN_EPS);
#pragma unroll
        for (int j = 0; j < 4; ++j) xr[64 * j] = v[j] * rstd * gv[j] + bv[j];
    }
}

typedef short bf16x8 __attribute__((ext_vector_type(8)));
typedef short s16x4 __attribute__((ext_vector_type(4)));
typedef float f32x16 __attribute__((ext_vector_type(16)));
typedef short v4i16_t __attribute__((ext_vector_type(4)));
#define MFMA32(a, b, c) __builtin_amdgcn_mfma_f32_32x32x16_bf16((a), (b), (c), 0, 0, 0)
__device__ __forceinline__ s16x4 vtr(const LAS unsigned char* p) { return __builtin_bit_cast(s16x4, __builtin_amdgcn_ds_read_tr16_b64_v4i16((LAS v4i16_t*)p)); }
__device__ __forceinline__ bf16x8 pack8(float a0, float a1, float a2, float a3, float a4, float a5, float a6, float a7) {
    u32x4 w; w.x = pk2(a0, a1); w.y = pk2(a2, a3); w.z = pk2(a4, a5); w.w = pk2(a6, a7); return __builtin_bit_cast(bf16x8, w); }
__device__ __forceinline__ bf16x8 scale8(u32x4 q, float c) {
    return pack8(__uint_as_float(q.x << 16) * c, __uint_as_float(q.x & 0xffff0000u) * c, __uint_as_float(q.y << 16) * c, __uint_as_float(q.y & 0xffff0000u) * c,
                 __uint_as_float(q.z << 16) * c, __uint_as_float(q.z & 0xffff0000u) * c, __uint_as_float(q.w << 16) * c, __uint_as_float(q.w & 0xffff0000u) * c); }
__device__ __forceinline__ void wg_sync() { asm volatile("s_waitcnt vmcnt(0) lgkmcnt(0)" ::: "memory"); __builtin_amdgcn_s_barrier(); asm volatile("" ::: "memory"); }

__device__ __forceinline__ void glds16(const void* gsrc, unsigned lds_dst) { unsigned keep; const unsigned d = __builtin_amdgcn_readfirstlane(lds_dst);
    asm volatile("s_mov_b32 %0, m0\n\ts_mov_b32 m0, %2\n\ts_nop 0\n\tglobal_load_lds_dwordx4 %1, off\n\ts_mov_b32 m0, %0" : "=&s"(keep) : "v"(gsrc), "s"(d) : "memory"); }
template <int NKC, int NVB>
__device__ __forceinline__ void stage_tile(LAS unsigned char* buf, const bf16_t* ktile, int kpitch, const bf16_t* vtile, int vpitch, int wid, int lane) {
    constexpr int NP = NKC + 4 * NVB;
    const unsigned kl = (unsigned)lane * (unsigned)kpitch * 2u;
    const unsigned vl = ((unsigned)(lane >> 2) * (unsigned)vpitch + (unsigned)(lane & 3) * 8u) * 2u;
#pragma unroll
    for (int i = 0; i < (NP + 7) / 8; ++i) {
        const int pc = i * 8 + wid;
        if (pc < NP) {
            const char* ub; unsigned vo;
            if (pc < NKC) { ub = (const char*)ktile + pc * 16; vo = kl; }
            else { const int pv = pc - NKC, db = pv >> 2, kg = pv & 3; ub = (const char*)vtile + ((size_t)kg * 16 * vpitch + db * 32) * 2; vo = vl; }
            __builtin_amdgcn_global_load_lds((const unsigned*)(ub + vo), (LAS unsigned*)(buf + pc * 1024), 16, 0, 0);
        }
    }
}
__device__ __forceinline__ void wait_vm_bar(int n_pieces) {
    switch (n_pieces) {
        case 0: asm volatile("s_waitcnt vmcnt(0)" ::: "memory"); break;
        case 2: asm volatile("s_waitcnt vmcnt(2)" ::: "memory"); break;
        case 3: asm volatile("s_waitcnt vmcnt(3)" ::: "memory"); break;
        case 4: asm volatile("s_waitcnt vmcnt(4)" ::: "memory"); break;
        case 6: asm volatile("s_waitcnt vmcnt(6)" ::: "memory"); break;
        case 8: asm volatile("s_waitcnt vmcnt(8)" ::: "memory"); break;
        case 9: asm volatile("s_waitcnt vmcnt(9)" ::: "memory"); break;
        case 12: asm volatile("s_waitcnt vmcnt(12)" ::: "memory"); break;
        default: asm volatile("s_waitcnt vmcnt(0)" ::: "memory"); break;
    }
    asm volatile("s_waitcnt lgkmcnt(0)" ::: "memory"); __builtin_amdgcn_s_barrier(); asm volatile("" ::: "memory");
}
template <int NST, int PPW, class StageFn, class ComputeFn>
__device__ __forceinline__ void tile_stream(int tb, int te, StageFn stage, ComputeFn compute) {
#pragma unroll
    for (int s2 = 0; s2 < NST - 1; ++s2) if (tb + s2 <= te) stage(tb + s2, s2);
    int slot = 0;
    for (int t = tb; t <= te; ++t) {
        int ahead = te - t; ahead = ahead > NST - 2 ? NST - 2 : ahead;
        wait_vm_bar(ahead * PPW);
        int ns = slot + NST - 1; ns = ns >= NST ? ns - NST : ns;
        if (t + NST - 1 <= te) stage(t + NST - 1, ns);
        compute(t, slot);
        slot = (slot + 1 == NST) ? 0 : slot + 1;
    }
}

__device__ __forceinline__ float max3f(float a, float b, float c) { float r; asm("v_max3_f32 %0, %1, %2, %3" : "=v"(r) : "v"(a), "v"(b), "v"(c)); return r; }
__device__ __forceinline__ float max2f(float a, float b) { float r; asm("v_max_f32_e32 %0, %1, %2" : "=v"(r) : "v"(a), "v"(b)); return r; }
template <int OFF> __device__ __forceinline__ bf16x8 lds_r128(unsigned addr) { bf16x8 v; asm volatile("ds_read_b128 %0, %1 offset:%2" : "=v"(v) : "v"(addr), "i"(OFF)); return v; }
template <int OFF> __device__ __forceinline__ s16x4 lds_rtr(unsigned addr) { s16x4 v; asm volatile("ds_read_b64_tr_b16 %0, %1 offset:%2" : "=v"(v) : "v"(addr), "i"(OFF)); return v; }
#define LGKM_WAIT(n) do { asm volatile("s_waitcnt lgkmcnt(" #n ")" ::: "memory"); __builtin_amdgcn_sched_barrier(0); } while (0)
struct VFrag { s16x4 lo[4], hi[4]; };
__device__ __forceinline__ void vfrag_read(VFrag& f, unsigned va) {
    f.lo[0] = lds_rtr<0>(va); f.hi[0] = lds_rtr<512>(va); f.lo[1] = lds_rtr<1024>(va); f.hi[1] = lds_rtr<1536>(va);
    f.lo[2] = lds_rtr<2048>(va); f.hi[2] = lds_rtr<2560>(va); f.lo[3] = lds_rtr<3072>(va); f.hi[3] = lds_rtr<3584>(va);
}
#define VFR(f, k) (bf16x8){f.lo[k][0], f.lo[k][1], f.lo[k][2], f.lo[k][3], f.hi[k][0], f.hi[k][1], f.hi[k][2], f.hi[k][3]}
template <int DQ, int NDB, bool MASKED, class Post>
__device__ __forceinline__ void attn_qk_sm(const LAS unsigned char* kb, const bf16x8 (&qr)[DQ / 16], f32x16 p0, f32x16 p1,
                                           f32x16 (&o)[NDB], float& m, float& l, bool first, float& seen, int lane, Post post, bf16x8 (&pf)[4]) {
    constexpr float THR = 8.0f;
    const int r32 = lane & 31, hi = lane >> 5;
    const unsigned kaddr = (unsigned)(unsigned long)(kb + hi * 1024 + r32 * 16);
#pragma unroll
    for (int g = 0; g < DQ / 64; ++g) {
        const unsigned ka = kaddr + g * 8192;
        {   const bf16x8 k0 = lds_r128<0>(ka), k1 = lds_r128<512>(ka), k2 = lds_r128<2048>(ka), k3 = lds_r128<2560>(ka);
            LGKM_WAIT(0);
            p0 = MFMA32(k0, qr[4 * g], p0); p1 = MFMA32(k1, qr[4 * g], p1); p0 = MFMA32(k2, qr[4 * g + 1], p0); p1 = MFMA32(k3, qr[4 * g + 1], p1); }
        {   const bf16x8 k4 = lds_r128<4096>(ka), k5 = lds_r128<4608>(ka), k6 = lds_r128<6144>(ka), k7 = lds_r128<6656>(ka);
            LGKM_WAIT(0);
            p0 = MFMA32(k4, qr[4 * g + 2], p0); p1 = MFMA32(k5, qr[4 * g + 2], p1); p0 = MFMA32(k6, qr[4 * g + 3], p0); p1 = MFMA32(k7, qr[4 * g + 3], p1); }
    }
    post(p0, p1);
    asm volatile("s_nop 15\n\ts_nop 7" : "+v"(p0), "+v"(p1));
    float ma = max3f(p0[0], p0[1], p1[0]), mb = max3f(p0[2], p0[3], p1[1]); ma = max3f(ma, p1[2], p1[3]);
#pragma unroll
    for (int r = 4; r < 16; r += 4) { ma = max3f(ma, p0[r], p0[r + 1]); mb = max3f(mb, p0[r + 2], p0[r + 3]); ma = max3f(ma, p1[r], p1[r + 1]); mb = max3f(mb, p1[r + 2], p1[r + 3]); }
    float rm = max2f(ma, mb); rm = max2f(rm, __shfl_xor(rm, 32));
    float delta, alpha_on;
    if (MASKED) { const bool real = rm > -1e29f; delta = real ? ((seen == 0.f || rm > THR) ? rm : 0.f) : 0.f; alpha_on = seen; if (real) seen = 1.f; }
    else { delta = (first || rm > THR) ? rm : 0.f; alpha_on = first ? 0.f : 1.f; }
    if (__any(delta != 0.f)) {
        m += delta;
        const float alpha = (alpha_on != 0.f) ? __builtin_amdgcn_exp2f(-delta) : 1.0f;
#pragma unroll
        for (int r = 0; r < 16; ++r) { p0[r] -= delta; p1[r] -= delta; }
        l *= alpha;
#pragma unroll
        for (int db = 0; db < NDB; ++db) o[db] *= alpha;
    }
    float rs = 0.f;
#pragma unroll
    for (int r = 0; r < 16; ++r) { p0[r] = __builtin_amdgcn_exp2f(p0[r]); p1[r] = __builtin_amdgcn_exp2f(p1[r]); rs += p0[r] + p1[r]; }
    l += rs;
    pf[0] = pack8(p0[0], p0[1], p0[2], p0[3], p0[4], p0[5], p0[6], p0[7]); pf[1] = pack8(p0[8], p0[9], p0[10], p0[11], p0[12], p0[13], p0[14], p0[15]);
    pf[2] = pack8(p1[0], p1[1], p1[2], p1[3], p1[4], p1[5], p1[6], p1[7]); pf[3] = pack8(p1[8], p1[9], p1[10], p1[11], p1[12], p1[13], p1[14], p1[15]);
}
template <int NDB, bool PIPE>
__device__ __forceinline__ void attn_pv(const LAS unsigned char* vb, const bf16x8 (&pf)[4], f32x16 (&o)[NDB], int lane) {
    const int hi = lane >> 5;
    const unsigned vaddr = (unsigned)(unsigned long)(vb + (4 * hi + ((lane & 15) >> 2)) * 64 + ((lane >> 4) & 1) * 32 + (lane & 3) * 8);
    VFrag fa, fb;
    if (PIPE) {
        vfrag_read(fa, vaddr);
#pragma unroll
        for (int db = 0; db < NDB; ++db) {
            VFrag& cur = (db & 1) ? fb : fa; VFrag& nxt = (db & 1) ? fa : fb;
            if (db + 1 < NDB) { vfrag_read(nxt, vaddr + (db + 1) * 4096); LGKM_WAIT(8); } else { LGKM_WAIT(0); }
            o[db] = MFMA32(VFR(cur, 0), pf[0], o[db]); o[db] = MFMA32(VFR(cur, 1), pf[1], o[db]); o[db] = MFMA32(VFR(cur, 2), pf[2], o[db]); o[db] = MFMA32(VFR(cur, 3), pf[3], o[db]);
        }
    } else {
#pragma unroll
        for (int db = 0; db < NDB; ++db) {
            vfrag_read(fa, vaddr + db * 4096); LGKM_WAIT(0);
            o[db] = MFMA32(VFR(fa, 0), pf[0], o[db]); o[db] = MFMA32(VFR(fa, 1), pf[1], o[db]); o[db] = MFMA32(VFR(fa, 2), pf[2], o[db]); o[db] = MFMA32(VFR(fa, 3), pf[3], o[db]);
        }
    }
}
template <int DQ, int NDB, bool MASKED, class Post>
__device__ __forceinline__ void attn_step(const LAS unsigned char* kb, const LAS unsigned char* vb, const bf16x8 (&qr)[DQ / 16], f32x16 p0, f32x16 p1,
                                          f32x16 (&o)[NDB], float& m, float& l, bool first, float& seen, int lane, Post post) {
    bf16x8 pf[4];
    attn_qk_sm<DQ, NDB, MASKED>(kb, qr, p0, p1, o, m, l, first, seen, lane, post, pf);
    attn_pv<NDB, (DQ == 64)>(vb, pf, o, lane);
}
template <int NST, int PPW, class StageFn, class QkFn, class PvFn>
__device__ __forceinline__ void tile_stream_stag(int tb, int te, bool trailing, StageFn stage, QkFn qk, PvFn pv) {
#pragma unroll
    for (int s2 = 0; s2 < NST - 2; ++s2) if (tb + s2 <= te) stage(tb + s2, s2);
    int slot = 0, pslot = 0;
    for (int t = tb; t <= te; ++t) {
        int ahead = te - t; ahead = ahead > NST - 3 ? NST - 3 : ahead;
        wait_vm_bar(ahead * PPW);
        int ns = slot + NST - 2; ns = ns >= NST ? ns - NST : ns;
        if (t + NST - 2 <= te) stage(t + NST - 2, ns);
        if (trailing) { if (t > tb) pv(t - 1, pslot); qk(t, slot); }
        else { qk(t, slot); pv(t, slot); }
        pslot = slot; slot = (slot + 1 == NST) ? 0 : slot + 1;
    }
    if (trailing && te >= tb) pv(te, pslot);
}
__device__ __forceinline__ void store_o16(bf16_t* dst, const f32x16& o, float sc, int hi) {
#pragma unroll
    for (int g = 0; g < 4; ++g) { u32x2 w; w.x = pk2(o[4 * g] * sc, o[4 * g + 1] * sc); w.y = pk2(o[4 * g + 2] * sc, o[4 * g + 3] * sc); *(u32x2*)(dst + 8 * g + 4 * hi) = w; }
}


__device__ __forceinline__ int pop_unit(CParams& p, int ctr, LAS unsigned char* lds, int tid) {
    wg_sync();
    if (tid == 0) *(LAS int*)(lds + LDS_MISC + 2048) = atomicAdd((int*)(WSX + CT_QCTR) + ctr * 16, 1);
    wg_sync();
    return *(const LAS int*)(lds + LDS_MISC + 2048);
}
__device__ __forceinline__ void ph_norms(CParams& p, int layer, LAS unsigned char* lds, int WIDS) {
    const int tid = TIDX, lane = tid & 63, w = tid >> 6;
    const bf16_t* proj = (const bf16_t*)(WSX + WS_BIG);
    float mx[4] = {0.f, 0.f, 0.f, 0.f};
    for (int tok = BIDX * 8 + w; tok < T; tok += GDIM * 8) {
        const bf16_t* row = proj + (size_t)tok * NINP;
#pragma unroll
        for (int k = 0; k < 2; ++k) {
            const int off = (k == 0) ? OFF_QA : OFF_KA; const int width = 512;
            float ss = 0.f;
            if (lane * 8 < width) { const u32x4 v = *(const u32x4*)(row + off + lane * 8);
                const float e0 = __uint_as_float(v.x << 16), e1 = __uint_as_float(v.x & 0xffff0000u), e2 = __uint_as_float(v.y << 16), e3 = __uint_as_float(v.y & 0xffff0000u);
                const float e4 = __uint_as_float(v.z << 16), e5 = __uint_as_float(v.z & 0xffff0000u), e6 = __uint_as_float(v.w << 16), e7 = __uint_as_float(v.w & 0xffff0000u);
                ss = (e0 * e0 + e1 * e1) + (e2 * e2 + e3 * e3) + (e4 * e4 + e5 * e5) + (e6 * e6 + e7 * e7); }
            ss += __shfl_xor(ss, 1); ss += __shfl_xor(ss, 2); ss += __shfl_xor(ss, 4);
            mx[k] = fmaxf(mx[k], ss);
        }
    }
    LAS float* red = (LAS float*)(lds + LDS_MISC + 4096);
    __syncthreads();
#pragma unroll
    for (int k = 0; k < 4; ++k) { float v = mx[k];
#pragma unroll
        for (int o = 32; o > 0; o >>= 1) v = fmaxf(v, __shfl_xor(v, o));
        if (lane == 0) red[w * 4 + k] = v; }
    __syncthreads();
    if (tid < 4) { float v = red[tid]; for (int ww = 1; ww < 8; ++ww) v = fmaxf(v, red[ww * 4 + tid]); ((float*)(WSX + CT_NORM))[(layer * 512 + BIDX) * 4 + tid] = v; }
    __syncthreads();
}
__device__ __forceinline__ float norm_max(CParams& p, int layer, int k, int lane) {
    const float* arr = (const float*)(WSX + CT_NORM) + (size_t)layer * 512 * 4; float v = 0.f; const int G = GDIM;
    for (int bb = lane; bb < G; bb += 64) v = fmaxf(v, arr[bb * 4 + k]);
#pragma unroll
    for (int o = 32; o > 0; o >>= 1) v = fmaxf(v, __shfl_xor(v, o));
    return v;
}

__device__ __forceinline__ void cross_unit(CParams& p, LAS unsigned char* lds, int WIDS, int b, int h, int qb) {
    const int tid = TIDX, lane = tid & 63, wid = __builtin_amdgcn_readfirstlane(tid >> 6), r32 = lane & 31, hi = lane >> 5;
    const int qg = wid & 3, dvh = wid >> 2;
    const bf16_t* Qx = (const bf16_t*)(WSX + WS_BIG); const bf16_t* KV = (const bf16_t*)(WSX + WS_KV); bf16_t* O = (bf16_t*)(WSX + WS_B1);
    constexpr int TILE = 65536; const float c2 = 0.0625f * LOG2E;
    {
        const int tok = b * S + qb * 128 + qg * 32 + r32;
        bf16x8 qr[16];
#pragma unroll
        for (int d0 = 0; d0 < 16; ++d0) qr[d0] = scale8(*(const u32x4*)(Qx + (size_t)tok * D + h * 256 + d0 * 16 + hi * 8), c2);
        f32x16 o[4];
#pragma unroll
        for (int db = 0; db < 4; ++db)
#pragma unroll
            for (int r = 0; r < 16; ++r) o[db][r] = 0.f;
        float m = 0.f, l = 0.f, seen = 0.f;
        const bf16_t* kt0 = KV + (size_t)(b * NMEM) * 2048 + h * 256; const bf16_t* vt0 = kt0 + 1024;
        wg_sync();
        stage_tile<32, 8>(lds, kt0, 2048, vt0, 2048, wid, lane);
        for (int t = 0; t < 4; ++t) {
            wg_sync();
            if (t + 1 < 4) stage_tile<32, 8>(lds + ((t + 1) & 1) * TILE, kt0 + (size_t)(t + 1) * 64 * 2048, 2048, vt0 + (size_t)(t + 1) * 64 * 2048, 2048, wid, lane);
            const LAS unsigned char* buf = lds + (t & 1) * TILE;
            f32x16 z;
#pragma unroll
            for (int r = 0; r < 16; ++r) z[r] = -m;
            attn_step<256, 4, false>(buf, buf + 32768 + dvh * 16384, qr, z, z, o, m, l, t == 0, seen, lane, [](f32x16&, f32x16&) {});
        }
        l += __shfl_xor(l, 32); const float inv = 1.0f / l;
        { const int tid2 = TIDX, lane2 = tid2 & 63, wid2 = tid2 >> 6;
          const int tok2 = b * S + qb * 128 + (wid2 & 3) * 32 + (lane2 & 31);
          bf16_t* orow = O + (size_t)tok2 * D + h * 256 + (wid2 >> 2) * 128;
#pragma unroll
          for (int db = 0; db < 4; ++db) store_o16(orow + db * 32, o[db], inv, lane2 >> 5); }
    }
}

__device__ __forceinline__ void ph_band(CParams& p, int layer, LAS unsigned char* lds, int WIDS) {
    const int tid = TIDX, lane = tid & 63, wid = __builtin_amdgcn_readfirstlane(tid >> 6), r32 = lane & 31, hi = lane >> 5;
    const bf16_t* proj = (const bf16_t*)(WSX + WS_BIG); bf16_t* Y = (bf16_t*)(WSX + WS_B1);
    constexpr int TILE = 16384; const float c2 = 0.125f * LOG2E;
    LAS float* tbl = (LAS float*)(lds + 4 * TILE);
    for (int u = BIDX; u < NB * 4 * 16; u += GDIM) {
        const int qb = u & 15, h = (u >> 4) & 3, b = u >> 6;
        const int cw = 4 * qb + (wid >> 1), tq = 64 * cw + 32 * (wid & 1) + r32, tok = b * S + tq;
        bf16x8 qr[4];
#pragma unroll
        for (int d0 = 0; d0 < 4; ++d0) qr[d0] = scale8(*(const u32x4*)(proj + (size_t)tok * NINP + OFF_QB + h * 64 + d0 * 16 + hi * 8), c2);
        f32x16 o[2];
#pragma unroll
        for (int db = 0; db < 2; ++db)
#pragma unroll
            for (int r = 0; r < 16; ++r) o[db][r] = 0.f;
        float m = 0.f, l = 0.f, seen = 0.f;
        const int t0 = 4 * qb - 8 < 0 ? 0 : 4 * qb - 8, t1 = 4 * qb + 3;
        const bf16_t* kb0 = proj + (size_t)(b * S) * NINP + OFF_KB + h * 64; const bf16_t* vb0 = proj + (size_t)(b * S) * NINP + OFF_VB + h * 64;
        wg_sync();
        if (tid < 257) tbl[tid] = asg(p.relb)[(layer * 4 + h) * 257 + tid] * LOG2E;
        tile_stream<4, 2>(t0, t1,
            [&](int t, int slot) { stage_tile<8, 2>(lds + slot * TILE, kb0 + (size_t)t * 64 * NINP, NINP, vb0 + (size_t)t * 64 * NINP, NINP, wid, lane); },
            [&](int t, int slot) {
                if (t >= cw - 8 && t <= cw) {
                    const LAS unsigned char* buf = lds + slot * TILE;
                    f32x16 p0, p1;
                    if (cw - t >= 3) { const float cb = tbl[256] - m;
#pragma unroll
                        for (int r = 0; r < 16; ++r) { p0[r] = cb; p1[r] = cb; } }
                    else { const int rel0 = tq - (64 * t + 4 * hi);
#pragma unroll
                        for (int r = 0; r < 16; ++r) { const int c = (r & 3) + 8 * (r >> 2); int ra = rel0 - c, rb = rel0 - c - 32;
                            ra = ra < -128 ? -128 : (ra > 128 ? 128 : ra); rb = rb < -128 ? -128 : (rb > 128 ? 128 : rb);
                            p0[r] = tbl[ra + 128] - m; p1[r] = tbl[rb + 128] - m; } }
                    attn_step<64, 2, false>(buf, buf + 8192, qr, p0, p1, o, m, l, t == (cw - 8 < 0 ? 0 : cw - 8), seen, lane, [](f32x16&, f32x16&) {});
                } });
        l += __shfl_xor(l, 32); const float inv = 1.0f / l;
        bf16_t* orow = Y + (size_t)tok * D + 512 + h * 64;
#pragma unroll
        for (int db = 0; db < 2; ++db) store_o16(orow + db * 32, o[db], inv, hi);
    }
    wg_sync();
}

__device__ __forceinline__ void ph_diff(CParams& p, int layer, LAS unsigned char* lds, int WIDS) {
    const int tid0 = TIDX;
    const bf16_t* proj = (const bf16_t*)(WSX + WS_BIG); bf16_t* Y = (bf16_t*)(WSX + WS_B1);
    const float* lamp = (const float*)(WSX + CT_LAM); const float lam = lamp[layer * 2], lam_init = lamp[layer * 2 + 1];
    const float* gain = asg(p.dgain) + layer * 128;
    constexpr int TILE = 32768; const float c2 = 0.125f * LOG2E;
    const int G = GDIM, bid = BIDX; const int vcu = (G % 8 == 0) ? (bid % 8) * (G / 8) + bid / 8 : bid;
    LAS float* gl = (LAS float*)(lds + LDS_MISC + 1024);
    if (tid0 < 128) gl[tid0] = gain[tid0] * (1.0f - lam_init);
    const int nq = (G % 8 == 0) ? 8 : 1, qid = bid % nq, ctr = (layer * 3 + 0) * 8 + qid;
    const float Bq = c2 * sqrtf(norm_max(p, layer, 0, tid0 & 63) * norm_max(p, layer, 1, tid0 & 63)) * 1.01f;
    for (;;) {
        const int tid = TIDX, lane = tid & 63, wid = __builtin_amdgcn_readfirstlane(tid >> 6), r32 = lane & 31, hi = lane >> 5;
        const int qg = wid & 3, map = wid >> 2;
        const int idx = pop_unit(p, ctr, lds, tid);
        if (idx >= (NB * 4 * 32) / nq) break;
        const int u = (qid + nq * (idx >> 7)) * 128 + (idx & 3) * 32 + (31 - ((idx & 127) >> 2));
        const int qb = u & 31, h = (u >> 5) & 3, b = u >> 7;
        const int tq = 128 * qb + 32 * qg + r32, tok = b * S + tq, cq = 2 * qb + (qg >> 1);
        const float slope2 = exp2f(-(float)(2 * h + 1)) * LOG2E;
        bf16x8 qr[4];
#pragma unroll
        for (int d0 = 0; d0 < 4; ++d0) qr[d0] = scale8(*(const u32x4*)(proj + (size_t)tok * NINP + OFF_QA + h * 128 + map * 64 + d0 * 16 + hi * 8), c2);
        f32x16 o[4];
#pragma unroll
        for (int db = 0; db < 4; ++db)
#pragma unroll
            for (int r = 0; r < 16; ++r) o[db][r] = 0.f;
        float m = 0.f, l = 0.f, seen = 0.f;
        const int t1 = 2 * qb + 1;
        int ts = (int)ceilf(((float)(128 * qb - 63) - (160.0f + 2.0f * Bq) / slope2) * (1.0f / 64.0f)); ts = ts < 0 ? 0 : ts; ts = __builtin_amdgcn_readfirstlane(ts);
        const bf16_t* kb0 = proj + (size_t)(b * S) * NINP + OFF_KA + h * 128; const bf16_t* vb0 = proj + (size_t)(b * S) * NINP + OFF_VA + h * 128;
        wg_sync();
        tile_stream<4, 4>(ts, t1,
            [&](int t, int slot) { stage_tile<16, 4>(lds + slot * TILE, kb0 + (size_t)t * 64 * NINP, NINP, vb0 + (size_t)t * 64 * NINP, NINP, wid, lane); },
            [&](int t, int slot) {
                if (t <= cq) {
                    const LAS unsigned char* buf = lds + slot * TILE;
                    f32x16 p0, p1; const float dq = (float)(64 * t + 4 * hi - tq);
                    if (t == cq) {
#pragma unroll
                        for (int r = 0; r < 16; ++r) { const float c = (float)((r & 3) + 8 * (r >> 2)); p0[r] = fmaf(-slope2, fabsf(dq + c), -m); p1[r] = fmaf(-slope2, fabsf(dq + c + 32.0f), -m); }
                    } else { const float sb = slope2 * dq - m;
#pragma unroll
                        for (int r = 0; r < 16; ++r) { const float c = (float)((r & 3) + 8 * (r >> 2)); p0[r] = fmaf(slope2, c, sb); p1[r] = fmaf(slope2, c + 32.0f, sb); }
                    }
                    attn_step<64, 4, false>(buf + map * 8192, buf + 16384, qr, p0, p1, o, m, l, t == ts, seen, lane, [](f32x16&, f32x16&) {});
                } });
        l += __shfl_xor(l, 32); const float inv = 1.0f / l;
        wg_sync();
        LAS float* xch = (LAS float*)lds + qg * 4096 + r32;
        if (map == 1) {
#pragma unroll
            for (int db = 0; db < 4; ++db)
#pragma unroll
                for (int r = 0; r < 16; ++r) xch[(db * 32 + (r & 3) + 8 * (r >> 2) + 4 * hi) * 32] = o[db][r] * inv;
        }
        wg_sync();
        if (map == 0) {
            float ss = 0.f;
#pragma unroll
            for (int db = 0; db < 4; ++db)
#pragma unroll
                for (int r = 0; r < 16; ++r) { const float y = o[db][r] * inv - lam * xch[(db * 32 + (r & 3) + 8 * (r >> 2) + 4 * hi) * 32]; o[db][r] = y; ss += y * y; }
            ss += __shfl_xor(ss, 32);
            const float rn = rsqrtf(ss * (1.0f / 128.0f) + RMS_EPS);
            bf16_t* orow = Y + (size_t)tok * D + h * 128;
#pragma unroll
            for (int db = 0; db < 4; ++db)
#pragma unroll
                for (int g = 0; g < 4; ++g) { const int d = db * 32 + 8 * g + 4 * hi; const f32x4 gn = *(const LAS f32x4*)(gl + d);
                    u32x2 w; w.x = pk2(o[db][4 * g] * rn * gn[0], o[db][4 * g + 1] * rn * gn[1]); w.y = pk2(o[db][4 * g + 2] * rn * gn[2], o[db][4 * g + 3] * rn * gn[3]);
                    *(u32x2*)(orow + d) = w; }
        }
    }
    wg_sync();
}

__device__ __forceinline__ size_t isc_tri(int c) { return (size_t)4096 * (size_t)(c * (c + 1) / 2); }
#define ISC_PTR(b_) ((b_) < ISC_IN_WBIG ? (float*)(WSX + WS_WBIG) + (size_t)(b_) * ISC_BATCH : (float*)asg(p.out) + (size_t)((b_) - ISC_IN_WBIG) * ISC_BATCH)
#define MASK_PTR ((unsigned long long*)((unsigned char*)asg(p.out) + OUT_MASK))
__device__ __forceinline__ void wave_lds_sync() { asm volatile("s_waitcnt lgkmcnt(0)" ::: "memory"); }

__device__ __forceinline__ unsigned fkey32(float f) { const unsigned u = __float_as_uint(f); return (u & 0x80000000u) ? ~u : (u | 0x80000000u); }
__device__ __forceinline__ void d2_chunk_pair(CParams& p, int b, int cp, LAS unsigned char* lds, int WIDS) {
    const int tid = TIDX; int lane = tid & 63; const int wid = __builtin_amdgcn_readfirstlane(tid >> 6);
    unsigned long long* mask = MASK_PTR;
    LAS unsigned* hist = (LAS unsigned*)(lds + wid * 9216);
    LAS unsigned* list = hist + 1024;
    LAS unsigned* rowb = list + 1024;
    LAS unsigned* lcnt = rowb + 128;
    const float NINF = -INFINITY;
    const int lane0 = lane;
    f32x4 v[16];
#define D2_ROW_T(i2) (64 * (((i2) & 1) ? 63 - cp : cp) + wid + 8 * ((i2) >> 1))
#define D2_LOAD_ROW(tx) do { const int bl_ = b, t_ = (tx), c_ = t_ >> 6, n_ = 64 * (c_ + 1); \
        const float* row_ = ISC_PTR(bl_) + isc_tri(c_) + (size_t)(t_ & 63) * (size_t)n_; \
        _Pragma("unroll") for (int i = 0; i < 16; ++i) { if (256 * i + 4 * lane < n_) v[i] = *(const f32x4*)(row_ + 256 * i + 4 * lane); else v[i] = (f32x4){NINF, NINF, NINF, NINF}; } } while (0)
    D2_LOAD_ROW(D2_ROW_T(0));
    for (int i2 = 0; i2 < 16; ++i2) {
        int lane = lane0; asm volatile("" : "+v"(lane));
        const int t = D2_ROW_T(i2), c = t >> 6, n = 64 * (c + 1);
        rowb[lane] = 0u; rowb[lane + 64] = 0u; if (lane == 0) lcnt[0] = 0u;
        unsigned long long selbits = 0ull; bool rank_list = false; unsigned need_r = 0, cstar_r = 0;
        if (n <= 256) { selbits = (4 * lane < n) ? 0xFull : 0ull; }
        else {
            float lo = INFINITY, hi = NINF;
#pragma unroll
            for (int i = 0; i < 16; ++i) if (256 * i + 4 * lane < n) {
#pragma unroll
                for (int q = 0; q < 4; ++q) { lo = fminf(lo, v[i][q]); hi = fmaxf(hi, v[i][q]); } }
#pragma unroll
            for (int o = 32; o > 0; o >>= 1) { lo = fminf(lo, __shfl_xor(lo, o)); hi = fmaxf(hi, __shfl_xor(hi, o)); }
            const float scale = (hi > lo) ? 1024.0f / (hi - lo) : 0.f;
#pragma unroll
            for (int q = 0; q < 16; ++q) hist[q * 64 + lane] = 0u;
            wave_lds_sync();
#define BUCKET(x) min(1023, (int)(((x) - lo) * scale))
#pragma unroll
            for (int i = 0; i < 16; ++i) if (256 * i + 4 * lane < n) {
#pragma unroll
                for (int q = 0; q < 4; ++q) (void)__hip_atomic_fetch_add(hist + BUCKET(v[i][q]), 1u, __ATOMIC_RELAXED, __HIP_MEMORY_SCOPE_WORKGROUP); }
            wave_lds_sync();
            unsigned hb[16]; unsigned ssum = 0;
#pragma unroll
            for (int q = 0; q < 4; ++q) { const u32x4 x = *(const LAS u32x4*)(hist + 16 * lane + 4 * q); hb[4 * q] = x.x; hb[4 * q + 1] = x.y; hb[4 * q + 2] = x.z; hb[4 * q + 3] = x.w; ssum += x.x + x.y + x.z + x.w; }
            unsigned incl = ssum;
#pragma unroll
            for (int o = 1; o < 64; o <<= 1) { const unsigned tt = __shfl_down(incl, o); if (lane + o < 64) incl += tt; }
            const unsigned long long bal = __ballot(incl >= 256u);
            const int L = 63 - __clzll(bal);
            unsigned cum = incl - ssum, cab = 0, cst = 0; int bks = 0; bool found = false;
#pragma unroll
            for (int bk = 15; bk >= 0; --bk) { if (!found && cum + hb[bk] >= 256u) { found = true; bks = bk; cab = cum; cst = hb[bk]; } if (!found) cum += hb[bk]; }
            const int bstar = __shfl(16 * lane + bks, L); const unsigned cnt_above = __shfl(cab, L), cstar = __shfl(cst, L);
            const unsigned need = 256u - cnt_above;
            const bool listmode = (need != cstar);
#pragma unroll
            for (int i = 0; i < 16; ++i) if (256 * i + 4 * lane < n) {
#pragma unroll
                for (int q = 0; q < 4; ++q) { const int bk = BUCKET(v[i][q]);
                    if (bk > bstar || (bk == bstar && !listmode)) selbits |= 1ull << (4 * i + q);
                    else if (bk == bstar) { const unsigned slot = __hip_atomic_fetch_add(lcnt, 1u, __ATOMIC_RELAXED, __HIP_MEMORY_SCOPE_WORKGROUP);
                        if (slot < 512u) { list[2 * slot] = fkey32(v[i][q]); list[2 * slot + 1] = (unsigned)(256 * i + 4 * lane + q); } } } }
            if (listmode) {
                if (cstar <= 512u) { rank_list = true; need_r = need; cstar_r = cstar; }
                else {
                    unsigned long long Tk = 0ull;
                    for (int bit = 43; bit >= 0; --bit) { const unsigned long long trial = Tk | (1ull << bit); unsigned cc = 0;
#pragma unroll
                        for (int i = 0; i < 16; ++i) if (256 * i + 4 * lane < n) {
#pragma unroll
                            for (int q = 0; q < 4; ++q) { const unsigned long long ck = ((unsigned long long)fkey32(v[i][q]) << 12) | (unsigned long long)(4095 - (256 * i + 4 * lane + q));
                                cc += (BUCKET(v[i][q]) == bstar && ck >= trial) ? 1u : 0u; } }
#pragma unroll
                        for (int o = 32; o > 0; o >>= 1) cc += __shfl_xor(cc, o);
                        if (cc >= need) Tk = trial; }
#pragma unroll
                    for (int i = 0; i < 16; ++i) if (256 * i + 4 * lane < n) {
#pragma unroll
                        for (int q = 0; q < 4; ++q) { const unsigned long long ck = ((unsigned long long)fkey32(v[i][q]) << 12) | (unsigned long long)(4095 - (256 * i + 4 * lane + q));
                            if (BUCKET(v[i][q]) == bstar && ck >= Tk) selbits |= 1ull << (4 * i + q); } }
                }
            }
#undef BUCKET
        }
        if (i2 + 1 < 16) D2_LOAD_ROW(D2_ROW_T(i2 + 1));
        if (rank_list) {
            wave_lds_sync();
            for (unsigned e = lane; e < cstar_r; e += 64) { const unsigned mk = list[2 * e], mi = list[2 * e + 1]; unsigned rank = 0;
                for (unsigned j2 = 0; j2 < cstar_r; ++j2) { const unsigned k2 = list[2 * j2], i2 = list[2 * j2 + 1]; rank += (k2 > mk || (k2 == mk && i2 < mi)) ? 1u : 0u; }
                if (rank < need_r) (void)__hip_atomic_fetch_or(rowb + (mi >> 5), 1u << (mi & 31), __ATOMIC_RELAXED, __HIP_MEMORY_SCOPE_WORKGROUP); }
        }
#pragma unroll
        for (int i = 0; i < 16; ++i) { const unsigned nib = (unsigned)(selbits >> (4 * i)) & 0xFu;
            if (nib) (void)__hip_atomic_fetch_or(rowb + 8 * i + (lane >> 3), nib << (4 * (lane & 7)), __ATOMIC_RELAXED, __HIP_MEMORY_SCOPE_WORKGROUP); }
        wave_lds_sync();
        if (lane <= c) mask[((size_t)b * 64 + lane) * S + t] = (unsigned long long)rowb[2 * lane] | ((unsigned long long)rowb[2 * lane + 1] << 32);
        wave_lds_sync();
    }
#undef D2_LOAD_ROW
#undef D2_ROW_T
    wg_sync();
}

__device__ __forceinline__ void ph_d1(CParams& p, int round, LAS unsigned char* lds, int WIDS) {
    const int tid = TIDX, lane = tid & 63, wid = __builtin_amdgcn_readfirstlane(tid >> 6), r32 = lane & 31, hi = lane >> 5;
    const int qh = wid & 1, j = wid >> 1;
    const bf16_t* proj = (const bf16_t*)(WSX + WS_BIG);
    const int G = GDIM, bid = BIDX; const int vcu = (G % 8 == 0) ? (bid % 8) * (G / 8) + bid / 8 : bid;
    for (int s = vcu; s < 256; s += G) {
        const int b = s >> 5, cp = s & 31;
        for (int k2 = 0; k2 < 2; ++k2) {
            const int c = k2 == 0 ? cp : 63 - cp;
            wg_sync();
#pragma unroll
            for (int i = 0; i < 8; ++i) { const int pc = i * 8 + wid;
                __builtin_amdgcn_global_load_lds((const unsigned*)(proj + (size_t)(b * S + 64 * c + lane) * NINP + OFF_QI + pc * 8), (LAS unsigned*)(lds + pc * 1024), 16, 0, 0); }
            const int tokq = b * S + 64 * c + qh * 32 + r32;
            float w[8];
            { const u32x4 wv = *(const u32x4*)(proj + (size_t)tokq * NINP + OFF_WI); const float sc = 0.125f * 0.35355339059f;
              w[0] = __uint_as_float(wv.x << 16) * sc; w[1] = __uint_as_float(wv.x & 0xffff0000u) * sc; w[2] = __uint_as_float(wv.y << 16) * sc; w[3] = __uint_as_float(wv.y & 0xffff0000u) * sc;
              w[4] = __uint_as_float(wv.z << 16) * sc; w[5] = __uint_as_float(wv.z & 0xffff0000u) * sc; w[6] = __uint_as_float(wv.w << 16) * sc; w[7] = __uint_as_float(wv.w & 0xffff0000u) * sc; }
            LAS float* wq = (LAS float*)(lds + 65536) + qh * 32 + r32;
            if (hi == 0) {
#pragma unroll
                for (int h = 0; h < 8; ++h) wq[h * 64] = w[h]; }
            wg_sync();
            float* orow = ISC_PTR(b) + isc_tri(c) + (size_t)(qh * 32 + r32) * (size_t)(64 * (c + 1));
            const LAS unsigned char* qp = lds + hi * 1024 + (qh * 32 + r32) * 16;
            for (int t = j; t <= c; t += 4) {
                const bf16_t* kp = proj + (size_t)(b * S + 64 * t + r32) * NINP + OFF_KI + hi * 8;
                bf16x8 ka[2][4];
#pragma unroll
                for (int kh = 0; kh < 2; ++kh)
#pragma unroll
                    for (int d0 = 0; d0 < 4; ++d0) ka[kh][d0] = *(const bf16x8*)(kp + (size_t)kh * 32 * NINP + d0 * 16);
                f32x16 a0, a1;
#pragma unroll
                for (int r = 0; r < 16; ++r) { a0[r] = 0.f; a1[r] = 0.f; }
#define D1_QK(P0, P1, hh) do { _Pragma("unroll") for (int r = 0; r < 16; ++r) { P0[r] = 0.f; P1[r] = 0.f; } \
        _Pragma("unroll") for (int d0 = 0; d0 < 4; ++d0) { const bf16x8 bq = *(const LAS bf16x8*)(qp + ((hh) * 8 + 2 * d0) * 1024); P0 = MFMA32(ka[0][d0], bq, P0); P1 = MFMA32(ka[1][d0], bq, P1); } } while (0)
#define D1_ACC(P0, P1, hh) do { const float wh_ = wq[(hh) * 64]; \
        _Pragma("unroll") for (int r = 0; r < 16; ++r) { a0[r] = fmaf(wh_, __int_as_float(max(__float_as_int(P0[r]), 0)), a0[r]); a1[r] = fmaf(wh_, __int_as_float(max(__float_as_int(P1[r]), 0)), a1[r]); } \
        asm volatile("" : "+v"(a0), "+v"(a1)); } while (0)
                f32x16 pa0, pa1, pb0, pb1;
                D1_QK(pa0, pa1, 0);
#pragma unroll 1
                for (int h = 0; h < 8; h += 2) {
                    D1_QK(pb0, pb1, h + 1);
                    __builtin_amdgcn_sched_barrier(0);
                    D1_ACC(pa0, pa1, h);
                    if (h + 2 < 8) D1_QK(pa0, pa1, h + 2);
                    __builtin_amdgcn_sched_barrier(0);
                    D1_ACC(pb0, pb1, h + 1);
                }
#undef D1_QK
#undef D1_ACC
#pragma unroll
                for (int g = 0; g < 4; ++g) {
                    const f32x4 s0 = {a0[4 * g] + 0.f, a0[4 * g + 1] + 0.f, a0[4 * g + 2] + 0.f, a0[4 * g + 3] + 0.f};
                    const f32x4 s1 = {a1[4 * g] + 0.f, a1[4 * g + 1] + 0.f, a1[4 * g + 2] + 0.f, a1[4 * g + 3] + 0.f};
                    *(f32x4*)(orow + 64 * t + 8 * g + 4 * hi) = s0; *(f32x4*)(orow + 64 * t + 32 + 8 * g + 4 * hi) = s1;
                }
            }
        }
        wg_sync();
        d2_chunk_pair(p, b, cp, lds, WIDS);
    }
    wg_sync();
}

__device__ __forceinline__ void ph_d3(CParams& p, int layer, LAS unsigned char* lds, int WIDS) {
    const int tid = TIDX, lane = tid & 63, wid = __builtin_amdgcn_readfirstlane(tid >> 6), r32 = lane & 31, hi = lane >> 5;
    const int qg = wid;
    const bf16_t* proj = (const bf16_t*)(WSX + WS_BIG); bf16_t* Y = (bf16_t*)(WSX + WS_B1);
    const unsigned long long* mask = MASK_PTR;
    constexpr int TILE = 18432; const float c2 = 0.125f * LOG2E;
    const int G = GDIM, bid = BIDX; const int vcu = (G % 8 == 0) ? (bid % 8) * (G / 8) + bid / 8 : bid;
    const int nq = (G % 8 == 0) ? 8 : 1, qid = bid % nq, ctr = (layer * 3 + 1) * 8 + qid;
    for (;;) {
        const int idx = pop_unit(p, ctr, lds, tid);
        if (idx >= (NB * 4 * 16) / nq) break;
        const int u = (qid + nq * (idx >> 6)) * 64 + (idx & 3) * 16 + (15 - ((idx & 63) >> 2));
        const int qb = u & 15, h = (u >> 4) & 3, b = u >> 6;
        const int tq = 256 * qb + 32 * qg + r32, tok = b * S + tq, cq = 4 * qb + (qg >> 1);
        const float slope2 = exp2f(-(float)(2 * h + 2)) * LOG2E;
        bf16x8 qr[4];
#pragma unroll
        for (int d0 = 0; d0 < 4; ++d0) qr[d0] = scale8(*(const u32x4*)(proj + (size_t)tok * NINP + OFF_QC + h * 64 + d0 * 16 + hi * 8), c2);
        f32x16 o[2];
#pragma unroll
        for (int db = 0; db < 2; ++db)
#pragma unroll
            for (int r = 0; r < 16; ++r) o[db][r] = 0.f;
        float m = 0.f, l = 0.f, seen = 0.f;
        const int t1 = 4 * qb + 3;
        const bf16_t* kb0 = proj + (size_t)(b * S) * NINP + OFF_KC + h * 64; const bf16_t* vb0 = proj + (size_t)(b * S) * NINP + OFF_VC + h * 64;
        const unsigned* mbase = (const unsigned*)(mask + ((size_t)b * 64 * S + 256 * qb)) + wid * 64 + lane;
        wg_sync();
        tile_stream<4, 3>(0, t1,
            [&](int t, int slot) { stage_tile<8, 2>(lds + slot * TILE, kb0 + (size_t)t * 64 * NINP, NINP, vb0 + (size_t)t * 64 * NINP, NINP, wid, lane);
                __builtin_amdgcn_global_load_lds(mbase + (size_t)t * S * 2, (LAS unsigned*)(lds + slot * TILE + 16384 + wid * 256), 4, 0, 0); },
            [&](int t, int slot) {
                if (t <= cq) {
                    const LAS unsigned char* buf = lds + slot * TILE;
                    u32x2 mw; asm volatile("ds_read_b64 %0, %1 offset:16384\n\ts_waitcnt lgkmcnt(0)" : "=v"(mw) : "v"((unsigned)(unsigned long)(buf + (qg * 32 + r32) * 8)));
                    const unsigned wl = mw.x >> (4 * hi), wh = mw.y >> (4 * hi);
                    f32x16 p0, p1; const float dq = (float)(64 * t + 4 * hi - tq);
                    if (t == cq) {
#pragma unroll
                        for (int r = 0; r < 16; ++r) { const float c = (float)((r & 3) + 8 * (r >> 2)); p0[r] = fmaf(-slope2, fabsf(dq + c), -m); p1[r] = fmaf(-slope2, fabsf(dq + c + 32.0f), -m); }
                    } else { const float sb = slope2 * dq - m;
#pragma unroll
                        for (int r = 0; r < 16; ++r) { const float c = (float)((r & 3) + 8 * (r >> 2)); p0[r] = fmaf(slope2, c, sb); p1[r] = fmaf(slope2, c + 32.0f, sb); }
                    }
                    attn_step<64, 2, true>(buf, buf + 8192, qr, p0, p1, o, m, l, false, seen, lane, [wl, wh](f32x16& a, f32x16& bb) {
#pragma unroll
                        for (int r = 0; r < 16; ++r) { const int c = (r & 3) + 8 * (r >> 2);
                            const unsigned s0 = (unsigned)__builtin_amdgcn_sbfe((int)wl, c, 1), s1 = (unsigned)__builtin_amdgcn_sbfe((int)wh, c, 1);
                            a[r] = __uint_as_float((__float_as_uint(a[r]) & s0) | (0xF149F2CAu & ~s0)); bb[r] = __uint_as_float((__float_as_uint(bb[r]) & s1) | (0xF149F2CAu & ~s1)); } });
                } });
        l += __shfl_xor(l, 32); const float inv = 1.0f / l;
        bf16_t* orow = Y + (size_t)tok * D + 768 + h * 64;
#pragma unroll
        for (int db = 0; db < 2; ++db) store_o16(orow + db * 32, o[db], inv, hi);
    }
    wg_sync();
}

constexpr int NPHASES = 27;
__global__ void __launch_bounds__(512, 2) mega(Params p_unused) {
    CParams* const kp0 = (CParams*)__builtin_amdgcn_kernarg_segment_ptr();
#define p (*opqk(kp0))
    extern __shared__ __attribute__((aligned(16))) unsigned char lds_raw[];
    LAS unsigned char* ldsL = (LAS unsigned char*)lds_raw;
    float* ldsf = (float*)lds_raw;
    const int WIDS = __builtin_amdgcn_readfirstlane((int)threadIdx.x >> 6);
    const int tid = TIDX;
    for (int u = tid; u < (LDS_BYTES - LDS_MISC) / 4; u += 512) ((LAS unsigned*)(ldsL + LDS_MISC))[u] = 0u;
    __syncthreads();
    const int lo = p.ph_lo, hi = p.ph_hi; const bool one = (hi - lo) > 1;
    XcdBarrier bar; bar.bar = (unsigned*)(WSX + CT_BAR); bar.x = 0; bar.st = nullptr;
    if (one) bar = xcd_barrier_post((unsigned*)(WSX + CT_BAR), (volatile LAS unsigned*)(ldsL + LDS_MISC), WIDS);
    int ph = 0;
#define RUN (ph >= lo && ph < hi)
#define SEAM do { if (ph >= lo && ph + 1 < hi) xcd_barrier(bar, WIDS); ++ph; } while (0)
#define G GDIM
#define bid BIDX
#define vcu ((G % 8 == 0) ? (bid % 8) * (G / 8) + bid / 8 : bid)
#define B0 ((bf16_t*)(WSX + WS_B0))
#define B1 ((bf16_t*)(WSX + WS_B1))
#define BIG ((bf16_t*)(WSX + WS_BIG))
#define WSM ((bf16_t*)(WSX + WS_WSM))
#define WBIG ((bf16_t*)(WSX + WS_WBIG))

    if (RUN) { ph_prologue(p, WIDS); ph_prep_small(p, 0, ldsf, WIDS); }
    SEAM;
    for (int layer = 0; layer < 2; ++layer) {
        if (RUN) {
            { constexpr int KV_PM0 = (int)((WS_MEMB - WS_B0) / ((size_t)256 * D * 2)), KV_PN0 = (int)(WSM_WKV / ((size_t)256 * D));
              static_assert((WS_MEMB - WS_B0) % ((size_t)256 * D * 2) == 0 && WSM_WKV % ((size_t)256 * D) == 0, "KV tiles must sit on the tile grid of Hb / Win_t");
              pg8::Gemm g{B0, WSM + WSM_WIN, T, NINP, D}; pg8::ProjKvOrder so; so.init(T, NINP, G, bid, KV_PM0, KV_PN0);
              pg8::EpiProjKv E{BIG, NINP, (bf16_t*)(WSX + WS_KV), KV_PM0, KV_PN0};
              pg8::gemm_phase<pg8::EpiProjKv, pg8::ProjKvOrder, true, true>(ldsL, g, so, E, WIDS); }
        }
        SEAM;
        if (RUN) { ph_norms(p, layer, ldsL, WIDS); ph_d1(p, 0, ldsL, WIDS); }
        SEAM;
        if (RUN) { const int sub = p.sub; if (sub == 0 || sub == 1) ph_diff(p, layer, ldsL, WIDS); if (sub == 0 || sub == 2) ph_band(p, layer, ldsL, WIDS); if (sub == 0 || sub == 3) ph_d3(p, layer, ldsL, WIDS); }
        SEAM;
        if (RUN) { pg8::Gemm g{B1, WSM + WSM_WOUT, T, D, D}; pg8::StaticOrder so; so.init(T, D, G, bid); pg8::EpiResid E{B0, (bf16_t*)(WSX + WS_ZB)};
            pg8::gemm_phase<pg8::EpiResid, pg8::StaticOrder, true, true>(ldsL, g, so, E, WIDS); }
        SEAM;
        if (RUN) { if (p.sub != 7) ph_layernorm(p, asg(p.ln1g) + layer * D, asg(p.ln1b) + layer * D, WIDS); ph_prep_big(p, layer, ldsf, WIDS); }
        SEAM;
        if (RUN) {
            pg8::StaticOrder so; so.init(T, D, G, bid);
            { pg8::Gemm g{B0, WSM + WSM_WQ, T, D, D}; pg8::EpiStore E{BIG, D, 0};
              pg8::gemm_phase<pg8::EpiStore, pg8::StaticOrder, true, true>(ldsL, g, so, E, WIDS); }
            pg8::Unit u;
            for (int i = 0; so.next(i, u); ++i) { const int b = u.pm >> 4, qb0 = 2 * (u.pm & 15);
                for (int hq = 0; hq < 2; ++hq) cross_unit(p, ldsL, WIDS, b, u.pn, qb0 + hq); }
            __syncthreads();
        }
        SEAM;
        if (RUN) { pg8::Gemm g{B1, WSM + WSM_WO, T, D, D}; pg8::StaticOrder so; so.init(T, D, G, bid); pg8::EpiResid E{B0, (bf16_t*)(WSX + WS_ZB)};
            pg8::gemm_phase<pg8::EpiResid, pg8::StaticOrder, true, true>(ldsL, g, so, E, WIDS); }
        SEAM;
        if (RUN) { if (layer == 0) ph_layernorm(p, asg(p.ln2g) + layer * D, asg(p.ln2b) + layer * D, WIDS); else ph_ln_router(p, asg(p.ln2g) + layer * D, asg(p.ln2b) + layer * D, ldsL, WIDS); }
        SEAM;
        if (layer == 0) {
            if (RUN) { pg8::Gemm g{B0, WBIG, T, 2 * DFF, D}; pg8::StaticOrder so; so.init(T, 2 * DFF, G, bid); pg8::EpiSwiglu E{BIG, DFF, 0};
                pg8::gemm_phase<pg8::EpiSwiglu, pg8::StaticOrder, true, true>(ldsL, g, so, E, WIDS); }
            SEAM;
            if (RUN) { pg8::Gemm g{BIG, WBIG + WB_W2, T, D, DFF}; pg8::StaticOrder so; so.init(T, D, G, bid); pg8::EpiResid E{B0, (bf16_t*)(WSX + WS_ZB)};
                pg8::gemm_phase<pg8::EpiResid, pg8::StaticOrder, true, true>(ldsL, g, so, E, WIDS); }
            SEAM;
            if (RUN) { ph_layernorm(p, asg(p.ln3g) + layer * D, asg(p.ln3b) + layer * D, WIDS); ph_prep_small(p, 1, ldsf, WIDS); }
            SEAM;
        } else {
            if (RUN) ph_scatter(p, ldsL, WIDS);
            SEAM;
            { const int* cnt = (const int*)(WSX + CT_CNT); int nt = 0;
              for (int e = 0; e < 8; ++e) nt += (cnt[e] + 255) / 256;
              nt = __builtin_amdgcn_readfirstlane(nt);
              const int n0 = nt > 192 ? nt - 192 : 0;
              for (int k = 0; k <= 4; ++k) {
                if (RUN) {
                    int xl = 0;
                    if (k >= 1) { const int kk = k - 1, t0 = kk == 0 ? 0 : n0 + 64 * (kk - 1), nk = kk == 0 ? n0 : (nt - t0 < 64 ? (nt - t0 < 0 ? 0 : nt - t0) : 64);
                        bf16_t* Hk = BIG + (size_t)(kk & 1) * MOE_HB1; bf16_t* Xg = (bf16_t*)(WSX + WS_XG) + (size_t)t0 * 256 * D;
                        xl = 4 * nk - G; xl = xl < 0 ? 0 : (xl > G ? G : xl);
                        pg8::Gemm g{Hk, WBIG + WB_W2E, PASS_ROWS, D * NE, DFFE}; pg8::MoeOrder mo{(const int*)(WSX + CT_TILEE) + t0, nk, D / 256, G, vcu, 0, 0}; pg8::EpiStore E{Xg, D, D / 256};
                        pg8::gemm_phase<pg8::EpiStore, pg8::MoeOrder, true, true>(ldsL, g, mo, E, WIDS); }
                    if (k <= 3) { const int t0 = k == 0 ? 0 : n0 + 64 * (k - 1), nk = k == 0 ? n0 : (nt - t0 < 64 ? (nt - t0 < 0 ? 0 : nt - t0) : 64);
                        bf16_t* Hk = BIG + (size_t)(k & 1) * MOE_HB1; bf16_t* Xg = (bf16_t*)(WSX + WS_XG) + (size_t)t0 * 256 * D;
                        pg8::Gemm g{Xg, WBIG, PASS_ROWS, 2 * DFFE * NE, D}; pg8::MoeOrder mo{(const int*)(WSX + CT_TILEE) + t0, nk, 2 * DFFE / 256, G, vcu, xl, 3}; pg8::EpiSwiglu E{Hk, DFFE, 2 * DFFE / 256};
                        pg8::gemm_phase<pg8::EpiSwiglu, pg8::MoeOrder, true, true>(ldsL, g, mo, E, WIDS); }
                }
                SEAM;
              }
            }
            if (RUN) ph_combine_ln(p, asg(p.ln3g) + layer * D, asg(p.ln3b) + layer * D, WIDS);
            SEAM;
        }
    }
#undef RUN
#undef SEAM
#undef p
#undef G
#undef bid
#undef vcu
}

extern "C" void kernel_launch(void* const* d_in, const int* in_sizes, int n_in, void* d_out, int out_size, void* d_ws, size_t ws_size, hipStream_t stream) {
    static int grid = 0;
    if (grid == 0) {
        if (ws_size < WS_END || n_in < 27) { fprintf(stderr, "kernel_launch: workspace too small: %zu < %zu\n", ws_size, (size_t)WS_END); grid = -1; return; }
        int dev = 0, cus = 0;
        if (hipGetDevice(&dev) != hipSuccess || hipDeviceGetAttribute(&cus, hipDeviceAttributeMultiprocessorCount, dev) != hipSuccess) { grid = -1; return; }
        if (hipFuncSetAttribute((const void*)mega, hipFuncAttributeMaxDynamicSharedMemorySize, LDS_BYTES) != hipSuccess) { fprintf(stderr, "kernel_launch: hipFuncSetAttribute failed\n"); grid = -1; return; }
        int per_cu = 0; (void)hipOccupancyMaxActiveBlocksPerMultiprocessor(&per_cu, (const void*)mega, 512, LDS_BYTES); (void)hipGetLastError();
        if (per_cu < 1) fprintf(stderr, "kernel_launch: occupancy query says %d\n", per_cu);
        grid = cus;
    }
    if (grid < 0) return;
    (void)hipMemsetAsync((char*)d_ws + WS_CTL, 0, CTL_ZERO_BYTES, stream);
    Params p{};
    const float** pp = (const float**)&p;
    for (int i = 0; i < 27; ++i) pp[i] = (const float*)d_in[i];
    p.out = (float*)d_out; p.ws = (unsigned char*)d_ws;
#if MK_DUP_N > 0
    p.ph_lo = 0; p.ph_hi = MK_DUP_PH + 1; hipLaunchKernelGGL(mega, dim3(grid), dim3(512), LDS_BYTES, stream, p);
    for (int r = 0; r < MK_DUP_N; ++r) { (void)hipMemsetAsync((char*)d_ws + CT_QCTR, 0, 8192, stream); p.ph_lo = MK_DUP_PH; p.ph_hi = MK_DUP_PH + 1; p.sub = MK_DUP_SUB; hipLaunchKernelGGL(mega, dim3(grid), dim3(512), LDS_BYTES, stream, p); }
    p.sub = 0; p.ph_lo = MK_DUP_PH + 1; p.ph_hi = 1 << 20;
    (void)hipMemsetAsync((char*)d_ws + WS_CTL, 0, 16384, stream); (void)hipMemsetAsync((char*)d_ws + CT_QCTR + 4096, 0, 4096, stream);
    hipLaunchKernelGGL(mega, dim3(grid), dim3(512), LDS_BYTES, stream, p);
#elif MK_ONE_LAUNCH
    p.ph_lo = 0; p.ph_hi = 1 << 20;
    hipLaunchKernelGGL(mega, dim3(grid), dim3(512), LDS_BYTES, stream, p);
#else
    for (int k = 0; k < NPHASES; ++k) { p.ph_lo = k; p.ph_hi = k + 1; hipLaunchKernelGGL(mega, dim3(grid), dim3(512), LDS_BYTES, stream, p); }
#endif
}
```
